# Optimizing an MI355X kernel written in HIP

```python
import math
import jax
import jax.numpy as jnp
from jax import lax
import numpy as np

D_MODEL = 1024
BATCH = 4
SEQ = 4096
DEPTH = 4
DEC_BATCH = 16
DEC_SEQ = 32
PAST_LEN = 2048

CHUNK = 64
Q_BLOCK = 128
N_MIXERS = 3
N_A_LAYERS = (DEPTH + 2) // 3
N_B_LAYERS = (DEPTH + 1) // 3
N_C_LAYERS = DEPTH // 3
ROPE_THETA = 500000.0
EPS = 1e-6
D_SUB = 64
H_A = D_MODEL // (2 * D_SUB)
ROT_A = D_SUB // 4
H_B = 4
DQK_B = D_MODEL // (2 * H_B)
DV_B = D_MODEL // H_B
FORGET_BIAS = 3.0
H_C = 8
NOPE_C = 128
ROPE_C = 64
V_C = 128
Q_LORA = 384
KV_LORA = 256
D_FF = -(-8 * D_MODEL // (3 * 256)) * 256

kernel_name = 'hybrid_streaming_encoder_step'


def rmsnorm(x, g):
    xf = x.astype(jnp.float32)
    y = xf * lax.rsqrt(jnp.mean(xf * xf, axis=-1, keepdims=True) + EPS)
    return (y * g.astype(jnp.float32)).astype(x.dtype)


def rope(x, pos, rot):
    half = rot // 2
    inv = jnp.power(jnp.float32(ROPE_THETA), -jnp.arange(half, dtype=jnp.float32) * (2.0 / rot))
    ang = pos.astype(jnp.float32)[:, None] * inv[None, :]
    cos = jnp.cos(ang)[:, None, :]
    sin = jnp.sin(ang)[:, None, :]
    xr = x[..., :rot].astype(jnp.float32)
    x1, x2 = xr[..., :half], xr[..., half:]
    out = jnp.concatenate([x1 * cos - x2 * sin, x2 * cos + x1 * sin], axis=-1).astype(x.dtype)
    return jnp.concatenate([out, x[..., rot:]], axis=-1)


def chunk_mask(pos_q, pos_k):
    return (pos_k[None, :] // CHUNK) <= (pos_q[:, None] // CHUNK)


def sweep_queries(fn, qs, pos_q):
    T = pos_q.shape[0]
    if T <= Q_BLOCK:
        return fn(qs, pos_q)
    nb = T // Q_BLOCK
    qs_b = tuple(jnp.moveaxis(q.reshape(q.shape[0], nb, Q_BLOCK, *q.shape[2:]), 1, 0) for q in qs)
    out = lax.map(lambda a: fn(a[0], a[1]), (qs_b, pos_q.reshape(nb, Q_BLOCK)))
    out = jnp.moveaxis(out, 0, 1)
    return out.reshape(out.shape[0], T, *out.shape[3:])


def diff_attention(h, past_k, past_v, w_qkv, lam_vecs, g_sub, w_o, lambda_init):
    B, T, _ = h.shape
    P = 0 if past_k is None else past_k.shape[1]
    pos_q = P + jnp.arange(T, dtype=jnp.int32)
    pos_k = jnp.arange(P + T, dtype=jnp.int32)
    q, k, v = jnp.split(h @ w_qkv, 3, axis=-1)
    q = rope(q.reshape(B, T, 2 * H_A, D_SUB), pos_q, ROT_A).reshape(B, T, H_A, 2, D_SUB)
    k_row = rope(k.reshape(B, T, 2 * H_A, D_SUB), pos_q, ROT_A).reshape(B, T, H_A, 2 * D_SUB)
    v_row = v.reshape(B, T, H_A, 2 * D_SUB)
    k_all = k_row if past_k is None else jnp.concatenate([past_k.astype(k_row.dtype), k_row], axis=1)
    v_all = v_row if past_v is None else jnp.concatenate([past_v.astype(v_row.dtype), v_row], axis=1)
    k1, k2 = k_all[..., :D_SUB], k_all[..., D_SUB:]
    lv = lam_vecs.astype(jnp.float32)
    lam = jnp.exp(jnp.sum(lv[0] * lv[1])) - jnp.exp(jnp.sum(lv[2] * lv[3])) + lambda_init
    scale = D_SUB ** -0.5

    def block(qs, pq):
        q1, q2 = qs
        mask = chunk_mask(pq, pos_k)

        def probs(qq, kk):
            s = jnp.einsum('bqhd,bkhd->bhqk', qq, kk, preferred_element_type=jnp.float32) * scale
            return jax.nn.softmax(jnp.where(mask, s, -jnp.inf), axis=-1)

        p = probs(q1, k1) - lam * probs(q2, k2)
        return jnp.einsum('bhqk,bkhd->bqhd', p.astype(v_all.dtype), v_all)

    o = sweep_queries(block, (q[:, :, :, 0], q[:, :, :, 1]), pos_q)
    o = rmsnorm(o, g_sub) * (1.0 - lambda_init)
    return o.reshape(B, T, D_MODEL) @ w_o, k_row, v_row


def to_blocks(a, nb, L):
    B, T, H = a.shape[:3]
    a = a.reshape(B, nb, L, H, *a.shape[3:])
    return jnp.moveaxis(a, (1, 3), (0, 2))


def mlstm(h, c0, n0, m0, w_in, b_gates, g_out, w_out):
    B, T, _ = h.shape
    nqk, nv = H_B * DQK_B, H_B * DV_B
    f32 = jnp.float32
    proj = h @ w_in
    q = proj[..., :nqk].reshape(B, T, H_B, DQK_B).astype(f32)
    k = proj[..., nqk:2 * nqk].reshape(B, T, H_B, DQK_B).astype(f32) * (DQK_B ** -0.5)
    v = proj[..., 2 * nqk:2 * nqk + nv].reshape(B, T, H_B, DV_B).astype(f32)
    o_pre = proj[..., 2 * nqk + nv:2 * nqk + 2 * nv]
    gates = proj[..., 2 * nqk + 2 * nv:].astype(f32) + b_gates.astype(f32)
    ig = gates[..., :H_B]
    lf = jax.nn.log_sigmoid(gates[..., H_B:])
    L = CHUNK if T % CHUNK == 0 else T
    nb = T // L
    tril = jnp.tril(jnp.ones((L, L), dtype=bool))

    def step(carry, blk):
        C, n, m = carry
        qb, kb, vb, ib, fb = blk
        b = jnp.cumsum(fb, axis=-1)
        g = b[..., -1]
        dm = jnp.where(tril, b[..., :, None] - b[..., None, :] + ib[..., None, :], -jnp.inf)
        inter = b + m[..., None]
        m_t = jnp.maximum(inter, jnp.max(dm, axis=-1))
        w_ts = jnp.exp(dm - m_t[..., None])
        a = jnp.exp(inter - m_t)
        qk = jnp.einsum('bhtd,bhsd->bhts', qb, kb) * w_ts
        num = a[..., None] * jnp.einsum('bhtd,bhdv->bhtv', qb, C) + jnp.einsum('bhts,bhsv->bhtv', qk, vb)
        den = a * jnp.einsum('bhtd,bhd->bht', qb, n) + jnp.sum(qk, axis=-1)
        h_out = num / jnp.maximum(jnp.abs(den), jnp.exp(-m_t))[..., None]
        r = g[..., None] - b + ib
        m_new = jnp.maximum(g + m, jnp.max(r, axis=-1))
        wr = jnp.exp(r - m_new[..., None])
        decay = jnp.exp(g + m - m_new)
        kw = kb * wr[..., None]
        C_new = decay[..., None, None] * C + jnp.einsum('bhsd,bhsv->bhdv', kw, vb)
        n_new = decay[..., None] * n + jnp.sum(kw, axis=2)
        return (C_new, n_new, m_new), h_out

    carry0 = (c0.astype(f32), n0.astype(f32), m0.astype(f32))
    blocks = tuple(to_blocks(t, nb, L) for t in (q, k, v, ig, lf))
    (cT, nT, mT), hs = lax.scan(step, carry0, blocks)
    hs = jnp.moveaxis(hs, (0, 2), (1, 3)).reshape(B, T, H_B, DV_B)
    hn = rmsnorm(hs, g_out.reshape(H_B, DV_B)).astype(h.dtype).reshape(B, T, nv)
    out = (jax.nn.sigmoid(o_pre) * hn) @ w_out
    dt = h.dtype
    return out, cT.astype(dt), nT.astype(dt), mT.astype(dt)


def mla(h, past_kv, past_kr, w_dq, g_q, w_uq, w_dkv, g_kv, w_ukv, w_o):
    B, T, _ = h.shape
    P = 0 if past_kv is None else past_kv.shape[1]
    pos_q = P + jnp.arange(T, dtype=jnp.int32)
    pos_k = jnp.arange(P + T, dtype=jnp.int32)
    q = (rmsnorm(h @ w_dq, g_q) @ w_uq).reshape(B, T, H_C, NOPE_C + ROPE_C)
    q_nope = q[..., :NOPE_C]
    q_rope = rope(q[..., NOPE_C:], pos_q, ROPE_C)
    dkv = h @ w_dkv
    kv_row = rmsnorm(dkv[..., :KV_LORA], g_kv)
    kr_row = rope(dkv[..., KV_LORA:][:, :, None, :], pos_q, ROPE_C)[:, :, 0, :]
    kv_all = kv_row if past_kv is None else jnp.concatenate([past_kv.astype(kv_row.dtype), kv_row], axis=1)
    kr_all = kr_row if past_kr is None else jnp.concatenate([past_kr.astype(kr_row.dtype), kr_row], axis=1)
    kv = (kv_all @ w_ukv).reshape(B, P + T, H_C, NOPE_C + V_C)
    k_nope, v = kv[..., :NOPE_C], kv[..., NOPE_C:]
    scale = (NOPE_C + ROPE_C) ** -0.5

    def block(qs, pq):
        qn, qr = qs
        mask = chunk_mask(pq, pos_k)
        s = (jnp.einsum('bqhd,bkhd->bhqk', qn, k_nope, preferred_element_type=jnp.float32)
             + jnp.einsum('bqhr,bkr->bhqk', qr, kr_all, preferred_element_type=jnp.float32)) * scale
        p = jax.nn.softmax(jnp.where(mask, s, -jnp.inf), axis=-1)
        return jnp.einsum('bhqk,bkhd->bqhd', p.astype(v.dtype), v)

    o = sweep_queries(block, (q_nope, q_rope), pos_q)
    return o.reshape(B, T, H_C * V_C) @ w_o, kv_row, kr_row


def swiglu(h, w_in, w_out):
    a, b = jnp.split(h @ w_in, 2, axis=-1)
    return (jax.nn.silu(a) * b) @ w_out


def trunk(x, c, past, p):
    B = x.shape[0]
    a_k, a_v, b_c, b_n, b_m, c_kv, c_kr = [], [], [], [], [], [], []
    for i in range(DEPTH):
        kind, j = i % N_MIXERS, i // N_MIXERS
        mod = (jax.nn.silu(c) @ p['w_ada'][i] + p['b_ada'][i])[:, None, :]
        sh1, sc1, gt1, sh2, sc2, gt2 = jnp.split(mod, 6, axis=-1)
        h = rmsnorm(x, p['g_norm1'][i]) * (1.0 + sc1) + sh1
        if kind == 0:
            pk, pv = (None, None) if past is None else (past[0][j], past[1][j])
            out, kr, vr = diff_attention(h, pk, pv, p['w_a_qkv'][j], p['a_lambda'][j], p['g_a_sub'][j],
                                         p['w_a_o'][j], 0.8 - 0.6 * math.exp(-0.3 * i))
            a_k.append(kr)
            a_v.append(vr)
        elif kind == 1:
            if past is None:
                c0 = jnp.zeros((B, H_B, DQK_B, DV_B), jnp.float32)
                n0 = jnp.zeros((B, H_B, DQK_B), jnp.float32)
                m0 = jnp.zeros((B, H_B), jnp.float32)
            else:
                c0, n0, m0 = past[2][j], past[3][j], past[4][j]
            out, cT, nT, mT = mlstm(h, c0, n0, m0, p['w_b_in'][j], p['b_b_gates'][j], p['g_b_out'][j], p['w_b_out'][j])
            b_c.append(cT)
            b_n.append(nT)
            b_m.append(mT)
        else:
            pkv, pkr = (None, None) if past is None else (past[5][j], past[6][j])
            out, kvr, krr = mla(h, pkv, pkr, p['w_c_dq'][j], p['g_c_q'][j], p['w_c_uq'][j], p['w_c_dkv'][j],
                                p['g_c_kv'][j], p['w_c_ukv'][j], p['w_c_o'][j])
            c_kv.append(kvr)
            c_kr.append(krr)
        x = x + gt1 * out
        h = rmsnorm(x, p['g_norm2'][i]) * (1.0 + sc2) + sh2
        x = x + gt2 * swiglu(h, p['w_ffn_in'][i], p['w_ffn_out'][i])
    y = rmsnorm(x, p['g_final'])
    return y, (jnp.stack(a_k), jnp.stack(a_v), jnp.stack(b_c), jnp.stack(b_n), jnp.stack(b_m),
               jnp.stack(c_kv), jnp.stack(c_kr))


def setup_inputs(seed: int = 0) -> dict:
    key = jax.random.key(seed)
    ks = iter(jax.random.split(key, 48))
    d = D_MODEL

    def nrm(shape, scale):
        return jax.random.normal(next(ks), shape, jnp.float32) * scale

    n_b_in = 2 * H_B * DQK_B + 2 * H_B * DV_B + 2 * H_B
    return {
        'x_prompt': nrm((BATCH, SEQ, d), 1.0),
        'x_sample': nrm((DEC_BATCH, DEC_SEQ, d), 1.0),
        'c_prompt': nrm((BATCH, d), 1.0),
        'c_sample': nrm((DEC_BATCH, d), 1.0),
        'cache_a_k': nrm((N_A_LAYERS, DEC_BATCH, PAST_LEN, H_A, 2 * D_SUB), 1.0),
        'cache_a_v': nrm((N_A_LAYERS, DEC_BATCH, PAST_LEN, H_A, 2 * D_SUB), 1.0),
        'state_b_c': nrm((N_B_LAYERS, DEC_BATCH, H_B, DQK_B, DV_B), 0.1),
        'state_b_n': nrm((N_B_LAYERS, DEC_BATCH, H_B, DQK_B), 0.1),
        'state_b_m': nrm((N_B_LAYERS, DEC_BATCH, H_B), 0.5),
        'cache_c_kv': nrm((N_C_LAYERS, DEC_BATCH, PAST_LEN, KV_LORA), 1.0),
        'cache_c_kr': nrm((N_C_LAYERS, DEC_BATCH, PAST_LEN, ROPE_C), 1.0),
        'w_ada': nrm((DEPTH, d, 6 * d), 0.5 * d ** -0.5),
        'b_ada': nrm((DEPTH, 6 * d), 0.02),
        'g_norm1': 1.0 + nrm((DEPTH, d), 0.02),
        'g_norm2': 1.0 + nrm((DEPTH, d), 0.02),
        'w_a_qkv': nrm((N_A_LAYERS, d, 3 * d), d ** -0.5),
        'a_lambda': nrm((N_A_LAYERS, 4, D_SUB), 0.1),
        'g_a_sub': 1.0 + nrm((N_A_LAYERS, 2 * D_SUB), 0.02),
        'w_a_o': nrm((N_A_LAYERS, d, d), d ** -0.5),
        'w_b_in': nrm((N_B_LAYERS, d, n_b_in), d ** -0.5),
        'b_b_gates': jnp.concatenate([nrm((N_B_LAYERS, H_B), 0.1),
                                      FORGET_BIAS + nrm((N_B_LAYERS, H_B), 0.1)], axis=-1),
        'g_b_out': 1.0 + nrm((N_B_LAYERS, H_B * DV_B), 0.02),
        'w_b_out': nrm((N_B_LAYERS, H_B * DV_B, d), (H_B * DV_B) ** -0.5),
        'w_c_dq': nrm((N_C_LAYERS, d, Q_LORA), d ** -0.5),
        'g_c_q': 1.0 + nrm((N_C_LAYERS, Q_LORA), 0.02),
        'w_c_uq': nrm((N_C_LAYERS, Q_LORA, H_C * (NOPE_C + ROPE_C)), Q_LORA ** -0.5),
        'w_c_dkv': nrm((N_C_LAYERS, d, KV_LORA + ROPE_C), d ** -0.5),
        'g_c_kv': 1.0 + nrm((N_C_LAYERS, KV_LORA), 0.02),
        'w_c_ukv': nrm((N_C_LAYERS, KV_LORA, H_C * (NOPE_C + V_C)), KV_LORA ** -0.5),
        'w_c_o': nrm((N_C_LAYERS, H_C * V_C, d), (H_C * V_C) ** -0.5),
        'w_ffn_in': nrm((DEPTH, d, 2 * D_FF), d ** -0.5),
        'w_ffn_out': nrm((DEPTH, D_FF, d), D_FF ** -0.5),
        'g_final': 1.0 + nrm((d,), 0.02),
    }


def reference(x_prompt, x_sample, c_prompt, c_sample, cache_a_k, cache_a_v, state_b_c, state_b_n,
              state_b_m, cache_c_kv, cache_c_kr, w_ada, b_ada, g_norm1, g_norm2, w_a_qkv, a_lambda,
              g_a_sub, w_a_o, w_b_in, b_b_gates, g_b_out, w_b_out, w_c_dq, g_c_q, w_c_uq, w_c_dkv,
              g_c_kv, w_c_ukv, w_c_o, w_ffn_in, w_ffn_out, g_final):
    p = dict(w_ada=w_ada, b_ada=b_ada, g_norm1=g_norm1, g_norm2=g_norm2, w_a_qkv=w_a_qkv,
             a_lambda=a_lambda, g_a_sub=g_a_sub, w_a_o=w_a_o, w_b_in=w_b_in, b_b_gates=b_b_gates,
             g_b_out=g_b_out, w_b_out=w_b_out, w_c_dq=w_c_dq, g_c_q=g_c_q, w_c_uq=w_c_uq,
             w_c_dkv=w_c_dkv, g_c_kv=g_c_kv, w_c_ukv=w_c_ukv, w_c_o=w_c_o, w_ffn_in=w_ffn_in,
             w_ffn_out=w_ffn_out, g_final=g_final)
    y_prompt, sp = trunk(x_prompt, c_prompt, None, p)
    past = (cache_a_k, cache_a_v, state_b_c, state_b_n, state_b_m, cache_c_kv, cache_c_kr)
    y_sample, ss = trunk(x_sample, c_sample, past, p)
    a_k_p, a_v_p, b_c_p, b_n_p, b_m_p, c_kv_p, c_kr_p = sp
    a_k_s, a_v_s, b_c_s, b_n_s, b_m_s, c_kv_s, c_kr_s = ss
    return (y_prompt, y_sample, a_k_p, a_v_p, b_c_p, b_n_p, b_m_p, c_kv_p, c_kr_p,
            a_k_s, a_v_s, b_c_s, b_n_s, b_m_s, c_kv_s, c_kr_s)
```

```cpp
#include <hip/hip_runtime.h>
#include <hip/hip_cooperative_groups.h>
#include <stdint.h>
#include <math.h>
#include <cstdio>
namespace cg = cooperative_groups;

#define DEV __device__ __forceinline__

typedef unsigned short bf16_t;
typedef __attribute__((ext_vector_type(8))) short bf16x8;
typedef __attribute__((ext_vector_type(4))) short bf16x4;
typedef __attribute__((ext_vector_type(4))) float f32x4;
typedef __attribute__((ext_vector_type(4))) unsigned int u32x4;

constexpr int MP = 16384;
constexpr int MS = 512;
constexpr int MA = MP + MS;
constexpr int SKV = 2080;
constexpr int KVROWS = MP + 16 * SKV;
constexpr int VTS_LD = 2112;
constexpr float EPSN = 1e-6f;
constexpr float LOG2E = 1.4426950408889634f;
constexpr float LOG2_THETA = 18.931568569324174f;

constexpr size_t O_YP = 0;
constexpr size_t O_YS = O_YP + (size_t)MP * 1024;
constexpr size_t O_AKP = O_YS + (size_t)MS * 1024;
constexpr size_t O_AVP = O_AKP + (size_t)2 * MP * 1024;
constexpr size_t O_BCP = O_AVP + (size_t)2 * MP * 1024;
constexpr size_t O_BNP = O_BCP + (size_t)16 * 128 * 256;
constexpr size_t O_BMP = O_BNP + (size_t)16 * 128;
constexpr size_t O_CKVP = O_BMP + 16;
constexpr size_t O_CKRP = O_CKVP + (size_t)MP * 256;
constexpr size_t O_AKS = O_CKRP + (size_t)MP * 64;
constexpr size_t O_AVS = O_AKS + (size_t)2 * MS * 1024;
constexpr size_t O_BCS = O_AVS + (size_t)2 * MS * 1024;
constexpr size_t O_BNS = O_BCS + (size_t)64 * 128 * 256;
constexpr size_t O_BMS = O_BNS + (size_t)64 * 128;
constexpr size_t O_CKVS = O_BMS + 64;
constexpr size_t O_CKRS = O_CKVS + (size_t)MS * 256;

constexpr size_t AL(size_t x) { return (x + 255) & ~(size_t)255; }
constexpr size_t W_QKV = 0;
constexpr size_t W_AO = W_QKV + AL((size_t)2 * 3072 * 1024 * 2);
constexpr size_t W_BIN = W_AO + AL((size_t)2 * 1024 * 1024 * 2);
constexpr size_t W_BOUT = W_BIN + AL((size_t)3200 * 1024 * 2);
constexpr size_t W_CD = W_BOUT + AL((size_t)1024 * 1024 * 2);
constexpr size_t W_UQ = W_CD + AL((size_t)768 * 1024 * 2);
constexpr size_t W_UKV = W_UQ + AL((size_t)1536 * 384 * 2);
constexpr size_t W_CO = W_UKV + AL((size_t)2048 * 256 * 2);
constexpr size_t W_FIN = W_CO + AL((size_t)1024 * 1024 * 2);
constexpr size_t W_FOUT = W_FIN + AL((size_t)4 * 5632 * 1024 * 2);
constexpr size_t B_MOD = W_FOUT + AL((size_t)4 * 1024 * 2816 * 2);
constexpr size_t B_ROPA = B_MOD + AL((size_t)4 * 20 * 6144 * 4);
constexpr size_t B_ROPC = B_ROPA + AL((size_t)4096 * 8 * 8);
constexpr size_t B_X = B_ROPC + AL((size_t)4096 * 32 * 8);
constexpr size_t B_H = B_X + AL((size_t)MA * 1024 * 4);
constexpr size_t B_ACT = B_H + AL((size_t)MA * 1024 * 2);
constexpr size_t B_Q = B_ACT + AL((size_t)MA * 2816 * 2);
constexpr size_t B_K = B_Q + AL((size_t)MA * 1536 * 2);
constexpr size_t B_VT = B_K + AL((size_t)KVROWS * 1536 * 2);
constexpr size_t VT_BYTES = AL((size_t)4 * 1024 * 4096 * 2 + (size_t)16 * 1024 * VTS_LD * 2);
constexpr size_t B_ATT = B_VT + VT_BYTES;
constexpr size_t B_BAR = B_ATT + AL((size_t)MA * 1024 * 2);
constexpr size_t B_PART = B_BAR + 16384;
constexpr size_t WS_TOTAL = B_PART + (size_t)16 * MS * 1024 * 4;
constexpr size_t C_RAW = B_ACT;
constexpr size_t C_QN = C_RAW + AL((size_t)MA * 768 * 4);
constexpr size_t C_KVB = C_QN + AL((size_t)MA * 384 * 2);
static_assert(C_KVB + (size_t)KVROWS * 256 * 2 <= B_Q, "mla alias");
constexpr size_t M_CT = B_ACT;
static_assert((size_t)1088 * 272 * 128 * 2 <= B_Q - B_ACT, "ct alias");
constexpr size_t M_KT = B_K + AL((size_t)MA * 512 * 2);
constexpr size_t M_OPRE = M_KT + AL((size_t)16 * 128 * 4096 * 2 + (size_t)64 * 128 * 32 * 2);
constexpr size_t M_GT = M_OPRE + AL((size_t)MA * 1024 * 2);
constexpr int NTOK_S = 16 * 4096 + 64 * 32;
constexpr size_t M_U = M_GT + AL((size_t)MA * 8 * 4);
constexpr size_t M_MT = M_U + AL((size_t)(NTOK_S + 64) * 4);
constexpr size_t M_BT = M_MT + AL((size_t)(NTOK_S + 64) * 4);
constexpr size_t M_WR = M_BT + AL((size_t)(NTOK_S + 64) * 4);
constexpr size_t M_MC = M_WR + AL((size_t)(NTOK_S + 64) * 4);
constexpr size_t M_DEC = M_MC + AL((size_t)1088 * 4);
static_assert(M_DEC + 1088 * 4 <= B_VT, "mlstm alias");
constexpr size_t M_VXP = B_VT;
constexpr size_t M_VXS = B_VT + AL((size_t)16 * 272 * 4096 * 2);
static_assert(M_VXS + (size_t)64 * 272 * 32 * 2 <= B_ATT, "vx alias");

constexpr int SMEM_BYTES = 65536;

struct Params {
  const float *x_prompt, *x_sample, *c_prompt, *c_sample, *cache_a_k, *cache_a_v, *state_b_c, *state_b_n,
      *state_b_m, *cache_c_kv, *cache_c_kr;
  const float *w_ada, *b_ada, *g_norm1, *g_norm2, *w_a_qkv, *a_lambda, *g_a_sub, *w_a_o, *w_b_in, *b_b_gates,
      *g_b_out, *w_b_out, *w_c_dq, *g_c_q, *w_c_uq, *w_c_dkv, *g_c_kv, *w_c_ukv, *w_c_o, *w_ffn_in, *w_ffn_out,
      *g_final;
  float* out;
  char* ws;
  float lam_init0, lam_init3;
};

DEV char* wsp(const Params& p) {
  const uint64_t w = (uint64_t)p.ws;
  uint32_t lo = __builtin_amdgcn_readfirstlane((uint32_t)w), hi = __builtin_amdgcn_readfirstlane((uint32_t)(w >> 32));
  asm volatile("" : "+s"(lo), "+s"(hi));
  return (char*)(((uint64_t)hi << 32) | lo);
}
typedef __bf16 bf16v2 __attribute__((ext_vector_type(2)));
typedef float f32v2 __attribute__((ext_vector_type(2)));
DEV uint32_t pack2(float a, float b) {
  f32v2 v = {a, b};
  bf16v2 r = __builtin_convertvector(v, bf16v2);
  return __builtin_bit_cast(uint32_t, r);
}
DEV bf16_t f2bf(float f) { return (bf16_t)(pack2(f, 0.f) & 0xffffu); }
DEV float bf2f(bf16_t h) { return __uint_as_float(((uint32_t)h) << 16); }
DEV uint2 pack4(float a, float b, float c, float d) { return make_uint2(pack2(a, b), pack2(c, d)); }
template <int M>
DEV float shx(float v) {
  return __int_as_float(__builtin_amdgcn_ds_swizzle(__float_as_int(v), (M << 10) | 0x1f));
}
DEV float shx32(float v, int lane) {
  return __int_as_float(__builtin_amdgcn_ds_bpermute((lane ^ 32) << 2, __float_as_int(v)));
}
DEV float shfl_lane(float v, int src) {
  return __int_as_float(__builtin_amdgcn_ds_bpermute(src << 2, __float_as_int(v)));
}
DEV float xrow16_max(float x) {
  auto s = __builtin_amdgcn_permlane16_swap(__float_as_uint(x), __float_as_uint(x), false, false);
  x = fmaxf(__uint_as_float(s[0]), __uint_as_float(s[1]));
  auto t = __builtin_amdgcn_permlane32_swap(__float_as_uint(x), __float_as_uint(x), false, false);
  return fmaxf(__uint_as_float(t[0]), __uint_as_float(t[1]));
}
DEV float xrow16_sum(float x) {
  auto s = __builtin_amdgcn_permlane16_swap(__float_as_uint(x), __float_as_uint(x), false, false);
  x = __uint_as_float(s[0]) + __uint_as_float(s[1]);
  auto t = __builtin_amdgcn_permlane32_swap(__float_as_uint(x), __float_as_uint(x), false, false);
  return __uint_as_float(t[0]) + __uint_as_float(t[1]);
}
DEV float wave_sum(float v, int lane) {
  v += shx32(v, lane);
  v += shx<16>(v); v += shx<8>(v); v += shx<4>(v); v += shx<2>(v); v += shx<1>(v);
  return v;
}
DEV float siluf(float a) { return a * __builtin_amdgcn_rcpf(1.f + __expf(-a)); }
DEV float sigmoidf(float a) { return __builtin_amdgcn_rcpf(1.f + __expf(-a)); }
DEV f32x4 mfma16(bf16x8 a, bf16x8 b, f32x4 c) { return __builtin_amdgcn_mfma_f32_16x16x32_bf16(a, b, c, 0, 0, 0); }
DEV bf16x8 ld8(const bf16_t* p) { return *reinterpret_cast<const bf16x8*>(p); }
DEV bf16x8 ld2x4(const bf16_t* p0, const bf16_t* p1) {
  bf16x4 a = *reinterpret_cast<const bf16x4*>(p0);
  bf16x4 b = *reinterpret_cast<const bf16x4*>(p1);
  return __builtin_shufflevector(a, b, 0, 1, 2, 3, 4, 5, 6, 7);
}
DEV bf16x8 packP(f32x4 a, f32x4 b) {
  u32x4 r = {pack2(a[0], a[1]), pack2(a[2], a[3]), pack2(b[0], b[1]), pack2(b[2], b[3])};
  return __builtin_bit_cast(bf16x8, r);
}
DEV int otid() { int t = threadIdx.x; asm volatile("" : "+v"(t)); return t; }
DEV int row_slot(int row) { return row < MP ? (row >> 12) : 4 + ((row - MP) >> 5); }
DEV int row_pos(int row) { return row < MP ? (row & 4095) : 2048 + ((row - MP) & 31); }
DEV int row_kv(int row) { return row < MP ? row : MP + ((row - MP) >> 5) * SKV + 2048 + ((row - MP) & 31); }

DEV int lds_byte(int r, int c) {
  const int st = (r >> 4) * 2 + (c >> 5), rr = r & 15, cc = c & 31, ob = rr * 64 + cc * 2;
  return st * 1024 + (ob ^ (((ob >> 9) & 1) << 5));
}
DEV void stage_rc(int b, int& R, int& C) {
  const int st = b >> 10, sb = b & 1023, swz = sb ^ (((sb >> 9) & 1) << 5);
  R = (st >> 1) * 16 + (swz >> 6);
  C = (st & 1) * 32 + ((swz & 63) >> 1);
}
DEV int gt_off(int r, int c16) { return (r >> 3) * 1024 + (r & 7) * 128 + ((c16 ^ ((r >> 1) & 7)) << 4); }
DEV void stage_tile128(const bf16_t* __restrict__ G, int ld, int k0, char* lds, int tid) {
#pragma unroll
  for (int i = 0; i < 4; ++i) {
    const int b = tid * 16 + i * 4096;
    const int R = (b >> 10) * 8 + ((b >> 7) & 7);
    const int C = ((((b >> 4) & 7) ^ ((R >> 1) & 7))) * 8;
    __builtin_amdgcn_global_load_lds((const __attribute__((address_space(1))) void*)(G + (size_t)R * ld + k0 + C),
                                     (__attribute__((address_space(3))) void*)(lds + b), 16, 0, 0);
  }
}
#define WAIT_VM(n) asm volatile("s_waitcnt vmcnt(" #n ")" ::: "memory")
#define WAIT_LGKM0() asm volatile("s_waitcnt lgkmcnt(0)" ::: "memory")

DEV void gemm_tile(const bf16_t* __restrict__ Ab, int lda, const bf16_t* __restrict__ Bb, int ldb, int kt0, int kt1,
                   f32x4 (&acc)[4][4], char* smem, const int (&aoff)[4][2], const int (&boff)[4][2], int tid) {
#pragma unroll
  for (int i = 0; i < 4; ++i)
#pragma unroll
    for (int j = 0; j < 4; ++j) acc[i][j] = (f32x4){0.f, 0.f, 0.f, 0.f};
  __syncthreads();
  stage_tile128(Ab, lda, kt0 * 64, smem, tid);
  stage_tile128(Bb, ldb, kt0 * 64, smem + 16384, tid);
  for (int kt = kt0; kt < kt1; ++kt) {
    char* cur = smem + ((kt - kt0) & 1) * 32768;
    if (kt + 1 < kt1) {
      char* nxt = smem + ((kt + 1 - kt0) & 1) * 32768;
      stage_tile128(Ab, lda, (kt + 1) * 64, nxt, tid);
      stage_tile128(Bb, ldb, (kt + 1) * 64, nxt + 16384, tid);
      WAIT_VM(8);
    } else {
      WAIT_VM(0);
    }
    __builtin_amdgcn_s_barrier();
#pragma unroll
    for (int ks = 0; ks < 2; ++ks) {
      bf16x8 af[4], bfr[4];
#pragma unroll
      for (int mi = 0; mi < 4; ++mi) af[mi] = *reinterpret_cast<const bf16x8*>(cur + aoff[mi][ks]);
#pragma unroll
      for (int ni = 0; ni < 4; ++ni) bfr[ni] = *reinterpret_cast<const bf16x8*>(cur + boff[ni][ks]);
#pragma unroll
      for (int mi = 0; mi < 4; ++mi)
#pragma unroll
        for (int ni = 0; ni < 4; ++ni) acc[mi][ni] = mfma16(af[mi], bfr[ni], acc[mi][ni]);
    }
    WAIT_LGKM0();
    __builtin_amdgcn_s_barrier();
  }
}

#define GEMM_SETUP()                                                                  \
  const int tid = otid(), lane = tid & 63, wave = tid >> 6;                           \
  const int wm = wave >> 1, wn = wave & 1;                                            \
  const int l15 = lane & 15, q4 = lane >> 4;                                          \
  int aoff[4][2], boff[4][2];                                                         \
  _Pragma("unroll") for (int i = 0; i < 4; ++i)                                       \
  _Pragma("unroll") for (int ks = 0; ks < 2; ++ks) {                                  \
    aoff[i][ks] = gt_off(wm * 64 + i * 16 + l15, ks * 4 + q4);                        \
    boff[i][ks] = 16384 + gt_off(wn * 64 + i * 16 + l15, ks * 4 + q4);                \
  }

template <class Epi>
DEV void gemm_phase(const bf16_t* __restrict__ A, int lda, const bf16_t* __restrict__ B, int ldb, int MT, int NT,
                    int K, const Epi& epi, char* smem) {
  GEMM_SETUP();
  const int KT = K >> 6;
  const int xcd = blockIdx.x & 7, xl = blockIdx.x >> 3, xstride = gridDim.x >> 3;
  const int m0 = (MT * xcd) >> 3, msz = ((MT * (xcd + 1)) >> 3) - m0;
  const int xcnt = msz * NT;
  for (int q = xl; q < xcnt; q += xstride) {
    const int tm = m0 + q % msz, tn = q / msz;
    f32x4 acc[4][4];
    gemm_tile(A + (size_t)tm * 128 * lda, lda, B + (size_t)tn * 128 * ldb, ldb, 0, KT, acc, smem, aoff, boff, tid);
    epi(tm * 128 + wm * 64, tn * 128 + wn * 64, acc, lane);
  }
  __syncthreads();
}

DEV void gemm_wide_tile(const bf16_t* __restrict__ Ab, int lda, const bf16_t* __restrict__ Bb, int ldb, int KT,
                        f32x4 (&accL)[4][4], f32x4 (&accR)[4][4], char* smem, const int (&aoff)[4][2],
                        const int (&boff)[8][2], int tid) {
#pragma unroll
  for (int i = 0; i < 4; ++i)
#pragma unroll
    for (int j = 0; j < 4; ++j) { accL[i][j] = (f32x4){0.f, 0.f, 0.f, 0.f}; accR[i][j] = (f32x4){0.f, 0.f, 0.f, 0.f}; }
  for (int kt = 0; kt < KT; ++kt) {
    __syncthreads();
    stage_tile128(Ab, lda, kt * 64, smem, tid);
    stage_tile128(Bb, ldb, kt * 64, smem + 16384, tid);
    stage_tile128(Bb + (size_t)128 * ldb, ldb, kt * 64, smem + 32768, tid);
    WAIT_VM(0);
    __builtin_amdgcn_s_barrier();
#pragma unroll
    for (int ks = 0; ks < 2; ++ks) {
      bf16x8 af[4], bfr[4];
#pragma unroll
      for (int mi = 0; mi < 4; ++mi) af[mi] = *reinterpret_cast<const bf16x8*>(smem + aoff[mi][ks]);
#pragma unroll
      for (int ni = 0; ni < 4; ++ni) bfr[ni] = *reinterpret_cast<const bf16x8*>(smem + boff[ni][ks]);
#pragma unroll
      for (int mi = 0; mi < 4; ++mi)
#pragma unroll
        for (int ni = 0; ni < 4; ++ni) accL[mi][ni] = mfma16(af[mi], bfr[ni], accL[mi][ni]);
#pragma unroll
      for (int ni = 0; ni < 4; ++ni) bfr[ni] = *reinterpret_cast<const bf16x8*>(smem + boff[4 + ni][ks]);
#pragma unroll
      for (int mi = 0; mi < 4; ++mi)
#pragma unroll
        for (int ni = 0; ni < 4; ++ni) accR[mi][ni] = mfma16(af[mi], bfr[ni], accR[mi][ni]);
    }
    WAIT_LGKM0();
  }
}

#define GEMM_WIDE_SETUP()                                                             \
  const int tid = otid(), lane = tid & 63, wave = tid >> 6;                           \
  const int wm = wave >> 1, wn = wave & 1;                                            \
  const int l15 = lane & 15, q4 = lane >> 4;                                          \
  int aoff[4][2], boff[8][2];                                                         \
  _Pragma("unroll") for (int ks = 0; ks < 2; ++ks) {                                  \
    _Pragma("unroll") for (int i = 0; i < 4; ++i) aoff[i][ks] = gt_off(wm * 64 + i * 16 + l15, ks * 4 + q4); \
    _Pragma("unroll") for (int i = 0; i < 8; ++i) boff[i][ks] = 16384 + wn * 16384 + gt_off(i * 16 + l15, ks * 4 + q4); \
  }

template <bool STASH, class Epi>
DEV void gemm_wide_phase(const bf16_t* __restrict__ A, int lda, const bf16_t* __restrict__ B, int ldb, int MT, int NT2,
                         int K, const Epi& epi, char* smem) {
  GEMM_WIDE_SETUP();
  const int KT = K >> 6;
  const int xcd = blockIdx.x & 7, xl = blockIdx.x >> 3, xstride = gridDim.x >> 3;
  const int m0 = (MT * xcd) >> 3, msz = ((MT * (xcd + 1)) >> 3) - m0;
  const int xcnt = msz * NT2;
  for (int q = xl; q < xcnt; q += xstride) {
    const int tm = m0 + q % msz, tn = q / msz;
    f32x4 accL[4][4], accR[4][4];
    gemm_wide_tile(A + (size_t)tm * 128 * lda, lda, B + (size_t)tn * 256 * ldb, ldb, KT, accL, accR, smem, aoff, boff, tid);
    if (STASH) {
      __syncthreads();
      f32x4* stp = (f32x4*)(smem + wave * 16384);
#pragma unroll
      for (int mi = 0; mi < 4; ++mi)
#pragma unroll
        for (int ni = 0; ni < 4; ++ni) stp[(mi * 4 + ni) * 64 + lane] = accR[mi][ni];
    }
    epi(tm * 128 + wm * 64, tn * 256 + wn * 128, accL, lane);
    if (STASH) {
      const f32x4* stp = (const f32x4*)(smem + wave * 16384);
#pragma unroll
      for (int mi = 0; mi < 4; ++mi)
#pragma unroll
        for (int ni = 0; ni < 4; ++ni) accR[mi][ni] = stp[(mi * 4 + ni) * 64 + lane];
    }
    epi(tm * 128 + wm * 64, tn * 256 + wn * 128 + 64, accR, lane);
  }
  __syncthreads();
}

template <class Epi>
DEV void gemm_res_phase(const bf16_t* __restrict__ A, int lda, const bf16_t* __restrict__ B, int ldb, int K, int KSPL,
                        const Epi& epi, float* part, char* smem) {
  constexpr int MTP = MP / 128;
  const int KT = K >> 6, KPER = KT / KSPL;
  {
    GEMM_WIDE_SETUP();
    const int xcd = blockIdx.x & 7, xl = blockIdx.x >> 3, xstride = gridDim.x >> 3;
    const int m0 = (MTP * xcd) >> 3, msz = ((MTP * (xcd + 1)) >> 3) - m0;
    const int xcnt = msz * 4;
    for (int q = xl; q < xcnt; q += xstride) {
      const int tm = m0 + q % msz, tn = q / msz;
      f32x4 accL[4][4], accR[4][4];
      gemm_wide_tile(A + (size_t)tm * 128 * lda, lda, B + (size_t)tn * 256 * ldb, ldb, KT, accL, accR, smem, aoff, boff, tid);
      epi(tm * 128 + wm * 64, tn * 256 + wn * 128, accL, lane);
      epi(tm * 128 + wm * 64, tn * 256 + wn * 128 + 64, accR, lane);
    }
  }
  {
    GEMM_SETUP();
    const int nsub = (MA / 128 - MTP) * 8 * KSPL;
    for (int sidx = blockIdx.x; sidx < nsub; sidx += gridDim.x) {
      const int kp = sidx % KSPL, st = sidx / KSPL;
      const int tm = MTP + (st & 3), tn = st >> 2;
      f32x4 acc[4][4];
      gemm_tile(A + (size_t)tm * 128 * lda, lda, B + (size_t)tn * 128 * ldb, ldb, kp * KPER, kp * KPER + KPER, acc, smem, aoff,
                boff, tid);
      epi.partial(tm * 128 + wm * 64, tn * 128 + wn * 64, acc, lane, part + (size_t)kp * MS * 1024);
    }
  }
  __syncthreads();
}

struct EpiRes {
  float* x;
  const float* gate;
  DEV void operator()(int rb, int cb, f32x4 (&acc)[4][4], int lane) const {
    const int l15 = lane & 15, q4 = lane >> 4;
#pragma unroll
    for (int mi = 0; mi < 4; ++mi)
#pragma unroll
      for (int jh = 0; jh < 4; jh += 2) {
        float xv[2][4], gv[2][4];
#pragma unroll
        for (int j = 0; j < 2; ++j) {
          const int row = rb + mi * 16 + q4 * 4 + jh + j;
          const int slot = row_slot(row);
#pragma unroll
          for (int ni = 0; ni < 4; ++ni) {
            const int col = cb + ni * 16 + l15;
            xv[j][ni] = x[(size_t)row * 1024 + col];
            gv[j][ni] = gate[slot * 6144 + col];
          }
        }
#pragma unroll
        for (int j = 0; j < 2; ++j) {
          const int row = rb + mi * 16 + q4 * 4 + jh + j;
#pragma unroll
          for (int ni = 0; ni < 4; ++ni) x[(size_t)row * 1024 + cb + ni * 16 + l15] = xv[j][ni] + gv[j][ni] * acc[mi][ni][jh + j];
        }
      }
  }
  DEV void partial(int rb, int cb, f32x4 (&acc)[4][4], int lane, float* part) const {
    const int l15 = lane & 15, q4 = lane >> 4;
#pragma unroll
    for (int mi = 0; mi < 4; ++mi)
#pragma unroll
      for (int j = 0; j < 4; ++j) {
        const int row = rb + mi * 16 + q4 * 4 + j;
        const int slot = row_slot(row);
#pragma unroll
        for (int ni = 0; ni < 4; ++ni) {
          const int col = cb + ni * 16 + l15;
          part[(size_t)(row - MP) * 1024 + col] = gate[slot * 6144 + col] * acc[mi][ni][j];
        }
      }
  }
};

struct EpiSwiglu {
  bf16_t* act;
  DEV void operator()(int rb, int cb, f32x4 (&acc)[4][4], int lane) const {
    const int l15 = lane & 15, q4 = lane >> 4;
#pragma unroll
    for (int mi = 0; mi < 4; ++mi)
#pragma unroll
      for (int j = 0; j < 4; ++j) {
        const int row = rb + mi * 16 + q4 * 4 + j;
#pragma unroll
        for (int ni = 0; ni < 4; ni += 2) {
          const float a = acc[mi][ni][j], b = acc[mi][ni + 1][j];
          const int oc = ((cb + ni * 16) >> 1) + l15;
          act[(size_t)row * 2816 + oc] = f2bf(siluf(a) * b);
        }
      }
  }
};

struct EpiF32 {
  float* raw;
  DEV void operator()(int rb, int cb, f32x4 (&acc)[4][4], int lane) const {
    const int l15 = lane & 15, q4 = lane >> 4;
#pragma unroll
    for (int mi = 0; mi < 4; ++mi)
#pragma unroll
      for (int j = 0; j < 4; ++j) {
        const int row = rb + mi * 16 + q4 * 4 + j;
#pragma unroll
        for (int ni = 0; ni < 4; ++ni) raw[(size_t)row * 768 + cb + ni * 16 + l15] = acc[mi][ni][j];
      }
  }
};

struct EpiQKV {
  bf16_t *Q, *Kall, *Vtp, *Vts;
  float *akp, *aks, *avp, *avs;
  const float2* ropa;
  DEV void operator()(int rb, int cb, f32x4 (&acc)[4][4], int lane) const {
    const int l15 = lane & 15, q4 = lane >> 4;
    const int part = cb >> 10, c0 = cb & 1023;
    if (part < 2) {
      f32v2 rt[4][4];
#pragma unroll
      for (int mi = 0; mi < 4; ++mi)
#pragma unroll
        for (int j = 0; j < 4; ++j) rt[mi][j] = ((const f32v2*)ropa)[row_pos(rb + mi * 16 + q4 * 4 + j) * 8 + (l15 & 7)];
#pragma unroll
      for (int mi = 0; mi < 4; ++mi)
#pragma unroll
        for (int j = 0; j < 4; ++j) {
          const float cs = rt[mi][j][0], sn = rt[mi][j][1];
          const float own = acc[mi][0][j];
          const float oth = shx<8>(own);
          acc[mi][0][j] = (l15 < 8) ? (own * cs - oth * sn) : (own * cs + oth * sn);
        }
      if (part == 0) {
        const float qs = 0.125f * LOG2E;
#pragma unroll
        for (int mi = 0; mi < 4; ++mi)
#pragma unroll
          for (int j = 0; j < 4; ++j) {
            const int row = rb + mi * 16 + q4 * 4 + j;
#pragma unroll
            for (int ni = 0; ni < 4; ++ni) Q[(size_t)row * 1024 + c0 + ni * 16 + l15] = f2bf(acc[mi][ni][j] * qs);
          }
      } else {
#pragma unroll
        for (int mi = 0; mi < 4; ++mi)
#pragma unroll
          for (int j = 0; j < 4; ++j) {
            const int row = rb + mi * 16 + q4 * 4 + j;
            const int kvr = row_kv(row);
            float* o = (row < MP) ? (akp + (size_t)row * 1024) : (aks + (size_t)(row - MP) * 1024);
#pragma unroll
            for (int ni = 0; ni < 4; ++ni) {
              const int c = c0 + ni * 16 + l15;
              __builtin_nontemporal_store(acc[mi][ni][j], o + c);
              Kall[(size_t)kvr * 1024 + c] = f2bf(acc[mi][ni][j]);
            }
          }
      }
    } else {
#pragma unroll
      for (int mi = 0; mi < 4; ++mi) {
        const int row0 = rb + mi * 16 + q4 * 4;
#pragma unroll
        for (int j = 0; j < 4; ++j) {
          const int row = row0 + j;
          float* o = (row < MP) ? (avp + (size_t)row * 1024) : (avs + (size_t)(row - MP) * 1024);
#pragma unroll
          for (int ni = 0; ni < 4; ++ni) __builtin_nontemporal_store(acc[mi][ni][j], o + c0 + ni * 16 + l15);
        }
#pragma unroll
        for (int ni = 0; ni < 4; ++ni) {
          const int c = c0 + ni * 16 + l15;
          bf16_t* d;
          if (row0 < MP) d = Vtp + ((size_t)((row0 >> 12) * 1024 + c)) * 4096 + (row0 & 4095);
          else { const int r = row0 - MP; d = Vts + ((size_t)((r >> 5) * 1024 + c)) * VTS_LD + 2048 + (r & 31); }
          *reinterpret_cast<uint2*>(d) = pack4(acc[mi][ni][0], acc[mi][ni][1], acc[mi][ni][2], acc[mi][ni][3]);
        }
      }
    }
  }
};

struct EpiBin {
  bf16_t *Qb, *Kb, *Ktp, *Kts, *Vxp, *Vxs, *Opre;
  float* Gt;
  DEV void operator()(int rb, int cb, f32x4 (&acc)[4][4], int lane) const {
    const int l15 = lane & 15, q4 = lane >> 4;
    if (cb < 512) {
#pragma unroll
      for (int mi = 0; mi < 4; ++mi)
#pragma unroll
        for (int j = 0; j < 4; ++j) {
          const int row = rb + mi * 16 + q4 * 4 + j;
#pragma unroll
          for (int ni = 0; ni < 4; ++ni) Qb[(size_t)row * 512 + cb + ni * 16 + l15] = f2bf(acc[mi][ni][j]);
        }
    } else if (cb < 1024) {
      const float ksc = 0.08838834764831845f;
#pragma unroll
      for (int mi = 0; mi < 4; ++mi) {
        const int row0 = rb + mi * 16 + q4 * 4;
#pragma unroll
        for (int ni = 0; ni < 4; ++ni) {
          const int c = cb - 512 + ni * 16 + l15;
          const float k0 = acc[mi][ni][0] * ksc, k1 = acc[mi][ni][1] * ksc, k2 = acc[mi][ni][2] * ksc,
                      k3 = acc[mi][ni][3] * ksc;
          Kb[(size_t)(row0 + 0) * 512 + c] = f2bf(k0);
          Kb[(size_t)(row0 + 1) * 512 + c] = f2bf(k1);
          Kb[(size_t)(row0 + 2) * 512 + c] = f2bf(k2);
          Kb[(size_t)(row0 + 3) * 512 + c] = f2bf(k3);
          bf16_t* d;
          if (row0 < MP) d = Ktp + ((size_t)((row0 >> 12) * 512 + c)) * 4096 + (row0 & 4095);
          else { const int r = row0 - MP; d = Kts + ((size_t)((r >> 5) * 512 + c)) * 32 + (r & 31); }
          *reinterpret_cast<uint2*>(d) = pack4(k0, k1, k2, k3);
        }
      }
    } else if (cb < 2048) {
#pragma unroll
      for (int mi = 0; mi < 4; ++mi) {
        const int row0 = rb + mi * 16 + q4 * 4;
#pragma unroll
        for (int ni = 0; ni < 4; ++ni) {
          const int c = cb - 1024 + ni * 16 + l15;
          const int hh = c >> 8, dv = c & 255;
          bf16_t* d;
          if (row0 < MP) d = Vxp + ((size_t)(((row0 >> 12) * 4 + hh) * 272 + dv)) * 4096 + (row0 & 4095);
          else { const int r = row0 - MP; d = Vxs + ((size_t)(((r >> 5) * 4 + hh) * 272 + dv)) * 32 + (r & 31); }
          *reinterpret_cast<uint2*>(d) = pack4(acc[mi][ni][0], acc[mi][ni][1], acc[mi][ni][2], acc[mi][ni][3]);
        }
      }
    } else if (cb < 3072) {
#pragma unroll
      for (int mi = 0; mi < 4; ++mi)
#pragma unroll
        for (int j = 0; j < 4; ++j) {
          const int row = rb + mi * 16 + q4 * 4 + j;
#pragma unroll
          for (int ni = 0; ni < 4; ++ni)
            Opre[(size_t)row * 1024 + cb - 2048 + ni * 16 + l15] = f2bf(sigmoidf(acc[mi][ni][j]));
        }
    } else if (cb == 3072) {
      if (l15 < 8) {
#pragma unroll
        for (int mi = 0; mi < 4; ++mi)
#pragma unroll
          for (int j = 0; j < 4; ++j) {
            const int row = rb + mi * 16 + q4 * 4 + j;
            Gt[(size_t)row * 8 + l15] = acc[mi][0][j];
          }
      }
    }
  }
};

struct EpiUQ {
  bf16_t* Qc;
  const float2* ropc;
  DEV void operator()(int rb, int cb, f32x4 (&acc)[4][4], int lane) const {
    const int l15 = lane & 15, q4 = lane >> 4;
    const int g = cb >> 6;
    if ((g % 3) == 2) {
      f32v2 r0t[4][4], r1t[4][4];
#pragma unroll
      for (int mi = 0; mi < 4; ++mi)
#pragma unroll
        for (int j = 0; j < 4; ++j) {
          const f32v2* rp = (const f32v2*)ropc + row_pos(rb + mi * 16 + q4 * 4 + j) * 32;
          r0t[mi][j] = rp[l15];
          r1t[mi][j] = rp[16 + l15];
        }
#pragma unroll
      for (int mi = 0; mi < 4; ++mi)
#pragma unroll
        for (int j = 0; j < 4; ++j) {
          {
            const f32v2 cssn = r0t[mi][j];
            const float x1 = acc[mi][0][j], x2 = acc[mi][2][j];
            acc[mi][0][j] = x1 * cssn[0] - x2 * cssn[1];
            acc[mi][2][j] = x2 * cssn[0] + x1 * cssn[1];
          }
          {
            const f32v2 cssn = r1t[mi][j];
            const float x1 = acc[mi][1][j], x2 = acc[mi][3][j];
            acc[mi][1][j] = x1 * cssn[0] - x2 * cssn[1];
            acc[mi][3][j] = x2 * cssn[0] + x1 * cssn[1];
          }
        }
    }
    const float qs = 0.07216878364870323f * LOG2E;
#pragma unroll
    for (int mi = 0; mi < 4; ++mi)
#pragma unroll
      for (int j = 0; j < 4; ++j) {
        const int row = rb + mi * 16 + q4 * 4 + j;
#pragma unroll
        for (int ni = 0; ni < 4; ++ni) Qc[(size_t)row * 1536 + cb + ni * 16 + l15] = f2bf(acc[mi][ni][j] * qs);
      }
  }
};

struct EpiUKV {
  bf16_t *Kf, *Vtp, *Vts;
  DEV void operator()(int rb, int cb, f32x4 (&acc)[4][4], int lane) const {
    const int l15 = lane & 15, q4 = lane >> 4;
    const int g = cb >> 6, head = g >> 2, part = g & 3;
    if (part < 2) {
#pragma unroll
      for (int mi = 0; mi < 4; ++mi)
#pragma unroll
        for (int j = 0; j < 4; ++j) {
          const int row = rb + mi * 16 + q4 * 4 + j;
#pragma unroll
          for (int ni = 0; ni < 4; ++ni)
            Kf[(size_t)row * 1536 + head * 192 + part * 64 + ni * 16 + l15] = f2bf(acc[mi][ni][j]);
        }
    } else {
#pragma unroll
      for (int mi = 0; mi < 4; ++mi) {
        const int row0 = rb + mi * 16 + q4 * 4;
#pragma unroll
        for (int ni = 0; ni < 4; ++ni) {
          const int c = head * 128 + (part - 2) * 64 + ni * 16 + l15;
          bf16_t* d;
          if (row0 < MP) d = Vtp + ((size_t)((row0 >> 12) * 1024 + c)) * 4096 + (row0 & 4095);
          else { const int r = row0 - MP; const int b = r / SKV; d = Vts + ((size_t)(b * 1024 + c)) * VTS_LD + (r - b * SKV); }
          *reinterpret_cast<uint2*>(d) = pack4(acc[mi][ni][0], acc[mi][ni][1], acc[mi][ni][2], acc[mi][ni][3]);
        }
      }
    }
  }
};

DEV void tconv_tile(const float* __restrict__ src, int R, int C, int lds_, bf16_t* __restrict__ dst, int ldd, int r0,
                    int c0, int mode, float* tile) {
  const int tx = otid() & 63, ty = otid() >> 6;
  float v[16];
#pragma unroll
  for (int i = 0; i < 16; ++i) {
    const int r = r0 + ty + 4 * i, c = c0 + tx;
    v[i] = (r < R && c < C) ? __builtin_nontemporal_load(src + (size_t)r * lds_ + c) : 0.f;
  }
  __syncthreads();
#pragma unroll
  for (int i = 0; i < 16; ++i) tile[(ty + 4 * i) * 65 + tx] = v[i];
  __syncthreads();
#pragma unroll
  for (int jj = 0; jj < 16; ++jj) {
    const int j = ty + 4 * jj;
    const int c = c0 + j, r = r0 + tx;
    if (c < C && r < R) {
      int cm = c;
      if (mode == 1) {
        if (c < 2816) cm = (c >> 4) * 32 + (c & 15);
        else { const int c2 = c - 2816; cm = (c2 >> 4) * 32 + 16 + (c2 & 15); }
      }
      dst[(size_t)cm * ldd + r] = f2bf(tile[tx * 65 + j]);
    }
  }
}

DEV bool pick(int& w, int n) {
  if (w < n) return true;
  w -= n;
  return false;
}

constexpr int P0_TCONV = 768 * 2 + 256 * 2 + 784 + 256 + 96 + 80 + 144 + 128 + 256 + 1408 * 4 + 704 * 4;
constexpr int P0_MOD = 384;
constexpr int P0_XCOPY = MA * 256 / 2048;
constexpr int P0_ROPE = 640;
constexpr int P0_TOTAL = P0_TCONV + P0_MOD + P0_XCOPY + P0_ROPE;

DEV void phase0(const Params& p, char* smem) {
  char* ws = wsp(p);
  const int tid = otid(), lane = tid & 63, wave = tid >> 6;
  for (int item = blockIdx.x; item < P0_TOTAL; item += gridDim.x) {
    int w = item;
    if (w < P0_TCONV) {
      const float* src; bf16_t* dst; int R, C, ldd, mode = 0;
      if (pick(w, 768)) { src = p.w_a_qkv; dst = (bf16_t*)(ws + W_QKV); R = 1024; C = 3072; ldd = 1024; }
      else if (pick(w, 768)) { src = p.w_a_qkv + (size_t)1024 * 3072; dst = (bf16_t*)(ws + W_QKV) + (size_t)3072 * 1024; R = 1024; C = 3072; ldd = 1024; }
      else if (pick(w, 256)) { src = p.w_a_o; dst = (bf16_t*)(ws + W_AO); R = 1024; C = 1024; ldd = 1024; }
      else if (pick(w, 256)) { src = p.w_a_o + (size_t)1024 * 1024; dst = (bf16_t*)(ws + W_AO) + (size_t)1024 * 1024; R = 1024; C = 1024; ldd = 1024; }
      else if (pick(w, 784)) { src = p.w_b_in; dst = (bf16_t*)(ws + W_BIN); R = 1024; C = 3080; ldd = 1024; }
      else if (pick(w, 256)) { src = p.w_b_out; dst = (bf16_t*)(ws + W_BOUT); R = 1024; C = 1024; ldd = 1024; }
      else if (pick(w, 96)) { src = p.w_c_dq; dst = (bf16_t*)(ws + W_CD); R = 1024; C = 384; ldd = 1024; }
      else if (pick(w, 80)) { src = p.w_c_dkv; dst = (bf16_t*)(ws + W_CD) + (size_t)384 * 1024; R = 1024; C = 320; ldd = 1024; }
      else if (pick(w, 144)) { src = p.w_c_uq; dst = (bf16_t*)(ws + W_UQ); R = 384; C = 1536; ldd = 384; }
      else if (pick(w, 128)) { src = p.w_c_ukv; dst = (bf16_t*)(ws + W_UKV); R = 256; C = 2048; ldd = 256; }
      else if (pick(w, 256)) { src = p.w_c_o; dst = (bf16_t*)(ws + W_CO); R = 1024; C = 1024; ldd = 1024; }
      else if (w < 1408 * 4) { const int l = w / 1408; w -= l * 1408; src = p.w_ffn_in + (size_t)l * 1024 * 5632; dst = (bf16_t*)(ws + W_FIN) + (size_t)l * 5632 * 1024; R = 1024; C = 5632; ldd = 1024; mode = 1; }
      else { w -= 1408 * 4; const int l = w / 704; w -= l * 704; src = p.w_ffn_out + (size_t)l * 2816 * 1024; dst = (bf16_t*)(ws + W_FOUT) + (size_t)l * 1024 * 2816; R = 2816; C = 1024; ldd = 2816; }
      const int ct = (C + 63) >> 6;
      const int rt = w / ct, cc = w - rt * ct;
      tconv_tile(src, R, C, C, dst, ldd, rt * 64, cc * 64, mode, (float*)smem);
    } else if (w < P0_TCONV + P0_MOD) {
      w -= P0_TCONV;
      const int layer = w / 96, cgp = w % 96;
      const int n = cgp * 64 + lane;
      const float* wa = p.w_ada + (size_t)layer * 1024 * 6144;
      float acc[20];
#pragma unroll
      for (int s = 0; s < 20; ++s) acc[s] = 0.f;
      for (int kb = 0; kb < 4; ++kb) {
        const int k0 = wave * 256 + kb * 64;
        float sv[20];
#pragma unroll
        for (int s = 0; s < 20; ++s) {
          const float cv = (s < 4) ? p.c_prompt[s * 1024 + k0 + lane] : p.c_sample[(s - 4) * 1024 + k0 + lane];
          sv[s] = siluf(cv);
        }
#pragma unroll 8
        for (int kk = 0; kk < 64; ++kk) {
          const float wv = __builtin_nontemporal_load(wa + (size_t)(k0 + kk) * 6144 + n);
#pragma unroll
          for (int s = 0; s < 20; ++s) acc[s] += __int_as_float(__builtin_amdgcn_readlane(__float_as_int(sv[s]), kk)) * wv;
        }
      }
      float* red = (float*)smem;
      __syncthreads();
#pragma unroll
      for (int s = 0; s < 20; ++s) red[(wave * 20 + s) * 64 + lane] = acc[s];
      __syncthreads();
      float* mod = (float*)(ws + B_MOD);
      for (int e = tid; e < 1280; e += 256) {
        const int s = e >> 6, c = e & 63;
        const float v = red[(0 * 20 + s) * 64 + c] + red[(1 * 20 + s) * 64 + c] + red[(2 * 20 + s) * 64 + c] +
                        red[(3 * 20 + s) * 64 + c] + p.b_ada[layer * 6144 + cgp * 64 + c];
        mod[(size_t)(layer * 20 + s) * 6144 + cgp * 64 + c] = v;
      }
    } else if (w >= P0_TCONV + P0_MOD + P0_XCOPY) {
      w -= P0_TCONV + P0_MOD + P0_XCOPY;
      const int e = w * 256 + tid;
      int pos, idx; float inv; float2* dstp;
      if (e < 32768) { pos = e >> 3; idx = e; inv = exp2f(-(float)(e & 7) * (LOG2_THETA / 8.f)); dstp = (float2*)(ws + B_ROPA); }
      else { const int e2 = e - 32768; pos = e2 >> 5; idx = e2; inv = exp2f(-(float)(e2 & 31) * (LOG2_THETA / 32.f)); dstp = (float2*)(ws + B_ROPC); }
      const float ang = (float)pos * inv;
      dstp[idx] = make_float2(cosf(ang), sinf(ang));
    } else {
      w -= P0_TCONV + P0_MOD;
      float4* xd = (float4*)(ws + B_X);
      f32x4 xv[8];
#pragma unroll
      for (int i = 0; i < 8; ++i) {
        const size_t idx = (size_t)w * 2048 + i * 256 + tid;
        const size_t row = idx >> 8;
        const f32x4* sp = (row < MP) ? ((const f32x4*)p.x_prompt + idx) : ((const f32x4*)p.x_sample + (idx - (size_t)MP * 256));
        xv[i] = __builtin_nontemporal_load(sp);
      }
#pragma unroll
      for (int i = 0; i < 8; ++i) ((f32x4*)xd)[(size_t)w * 2048 + i * 256 + tid] = xv[i];
    }
  }
}

DEV void norm_mod_phase(float* __restrict__ x, const float* __restrict__ g, const float* __restrict__ modl,
                        int shoff, int scoff, bf16_t* __restrict__ h, const float* __restrict__ part, int kspl) {
  const int lane = otid() & 63, wave = otid() >> 6;
  f32x4 gg[4];
#pragma unroll
  for (int i = 0; i < 4; ++i) gg[i] = ((const f32x4*)g)[lane + 64 * i];
  for (int row = blockIdx.x * 4 + wave; row < MA; row += gridDim.x * 4) {
    f32x4 v[4], sc[4], sh[4];
    const float* ms = modl + row_slot(row) * 6144;
#pragma unroll
    for (int i = 0; i < 4; ++i) {
      v[i] = ((const f32x4*)(x + (size_t)row * 1024))[lane + 64 * i];
      sc[i] = ((const f32x4*)(ms + scoff))[lane + 64 * i];
      sh[i] = ((const f32x4*)(ms + shoff))[lane + 64 * i];
    }
    if (row >= MP && kspl > 0) {
      for (int kp = 0; kp < kspl; ++kp) {
        const f32x4* pr = (const f32x4*)(part + ((size_t)kp * MS + (row - MP)) * 1024);
        f32x4 t[4];
#pragma unroll
        for (int i = 0; i < 4; ++i) t[i] = pr[lane + 64 * i];
#pragma unroll
        for (int i = 0; i < 4; ++i) v[i] += t[i];
      }
#pragma unroll
      for (int i = 0; i < 4; ++i) ((f32x4*)(x + (size_t)row * 1024))[lane + 64 * i] = v[i];
    }
    float ss = 0.f;
#pragma unroll
    for (int i = 0; i < 4; ++i) ss += v[i][0] * v[i][0] + v[i][1] * v[i][1] + v[i][2] * v[i][2] + v[i][3] * v[i][3];
    ss = wave_sum(ss, lane);
    const float r = rsqrtf(ss * (1.f / 1024.f) + EPSN);
#pragma unroll
    for (int i = 0; i < 4; ++i) {
      const int c4 = lane + 64 * i;
      const float y0 = v[i][0] * r * gg[i][0] * (1.f + sc[i][0]) + sh[i][0];
      const float y1 = v[i][1] * r * gg[i][1] * (1.f + sc[i][1]) + sh[i][1];
      const float y2 = v[i][2] * r * gg[i][2] * (1.f + sc[i][2]) + sh[i][2];
      const float y3 = v[i][3] * r * gg[i][3] * (1.f + sc[i][3]) + sh[i][3];
      *reinterpret_cast<uint2*>(h + (size_t)row * 1024 + c4 * 4) = pack4(y0, y1, y2, y3);
    }
  }
}

DEV void final_norm_phase(const float* __restrict__ x, const float* __restrict__ g, float* __restrict__ out,
                          const float* __restrict__ part, int kspl) {
  const int lane = otid() & 63, wave = otid() >> 6;
  f32x4 gg[4];
#pragma unroll
  for (int i = 0; i < 4; ++i) gg[i] = ((const f32x4*)g)[lane + 64 * i];
  for (int row = blockIdx.x * 4 + wave; row < MA; row += gridDim.x * 4) {
    f32x4 v[4];
    float ss = 0.f;
#pragma unroll
    for (int i = 0; i < 4; ++i) {
      v[i] = ((const f32x4*)(x + (size_t)row * 1024))[lane + 64 * i];
    }
    if (row >= MP && kspl > 0) {
      for (int kp = 0; kp < kspl; ++kp) {
        const f32x4* pr = (const f32x4*)(part + ((size_t)kp * MS + (row - MP)) * 1024);
        f32x4 t[4];
#pragma unroll
        for (int i = 0; i < 4; ++i) t[i] = pr[lane + 64 * i];
#pragma unroll
        for (int i = 0; i < 4; ++i) v[i] += t[i];
      }
    }
#pragma unroll
    for (int i = 0; i < 4; ++i) ss += v[i][0] * v[i][0] + v[i][1] * v[i][1] + v[i][2] * v[i][2] + v[i][3] * v[i][3];
    ss = wave_sum(ss, lane);
    const float r = rsqrtf(ss * (1.f / 1024.f) + EPSN);
    float* o = (row < MP) ? (out + O_YP + (size_t)row * 1024) : (out + O_YS + (size_t)(row - MP) * 1024);
#pragma unroll
    for (int i = 0; i < 4; ++i) {
      f32x4 y = v[i] * gg[i] * r;
      __builtin_nontemporal_store(y, (f32x4*)o + lane + 64 * i);
    }
  }
}

DEV void mla_norm_phase(const Params& p) {
  char* ws = wsp(p);
  const float* raw = (const float*)(ws + C_RAW);
  bf16_t* Qn = (bf16_t*)(ws + C_QN);
  bf16_t* KVB = (bf16_t*)(ws + C_KVB);
  bf16_t* Kf = (bf16_t*)(ws + B_K);
  const int lane = otid() & 63, wave = otid() >> 6;
  float gq[6], gkv[4];
#pragma unroll
  for (int i = 0; i < 6; ++i) gq[i] = p.g_c_q[lane + 64 * i];
#pragma unroll
  for (int i = 0; i < 4; ++i) gkv[i] = p.g_c_kv[lane + 64 * i];
  for (int row = blockIdx.x * 4 + wave; row < MA; row += gridDim.x * 4) {
    const float* rr = raw + (size_t)row * 768;
    const int kvr = row_kv(row);
    float v[6], u[4];
#pragma unroll
    for (int i = 0; i < 6; ++i) v[i] = rr[lane + 64 * i];
#pragma unroll
    for (int i = 0; i < 4; ++i) u[i] = rr[384 + lane + 64 * i];
    const float xr = rr[640 + lane];
    const f32v2 cssn = ((const f32v2*)(ws + B_ROPC))[row_pos(row) * 32 + (lane & 31)];
    float ss = 0.f;
#pragma unroll
    for (int i = 0; i < 6; ++i) ss += v[i] * v[i];
    ss = wave_sum(ss, lane);
    float r = rsqrtf(ss * (1.f / 384.f) + EPSN);
#pragma unroll
    for (int i = 0; i < 6; ++i) Qn[(size_t)row * 384 + lane + 64 * i] = f2bf(v[i] * r * gq[i]);
    ss = 0.f;
#pragma unroll
    for (int i = 0; i < 4; ++i) ss += u[i] * u[i];
    ss = wave_sum(ss, lane);
    r = rsqrtf(ss * (1.f / 256.f) + EPSN);
    float* okv = (row < MP) ? (p.out + O_CKVP + (size_t)row * 256) : (p.out + O_CKVS + (size_t)(row - MP) * 256);
#pragma unroll
    for (int i = 0; i < 4; ++i) {
      const float val = u[i] * r * gkv[i];
      okv[lane + 64 * i] = val;
      KVB[(size_t)kvr * 256 + lane + 64 * i] = f2bf(val);
    }
    const float oth = shx32(xr, lane);
    const float cs = cssn[0], sn = cssn[1];
    const float o = (lane < 32) ? (xr * cs - oth * sn) : (xr * cs + oth * sn);
    float* okr = (row < MP) ? (p.out + O_CKRP + (size_t)row * 64) : (p.out + O_CKRS + (size_t)(row - MP) * 64);
    okr[lane] = o;
    const bf16_t ob = f2bf(o);
#pragma unroll
    for (int hh = 0; hh < 8; ++hh) Kf[(size_t)kvr * 1536 + hh * 192 + 128 + lane] = ob;
  }
}

DEV void conv_cache_a(const Params& p, int j, char* smem) {
  char* ws = wsp(p);
  bf16_t* Kall = (bf16_t*)(ws + B_K);
  bf16_t* Vts = (bf16_t*)(ws + B_VT) + (size_t)4 * 1024 * 4096;
  const int tid = otid();
  for (int item = blockIdx.x; item < 4096 + 8192; item += gridDim.x) {
    if (item < 4096) {
      const int b = item >> 8, r0 = (item & 255) * 8;
      f32x4 kv[8];
#pragma unroll
      for (int i = 0; i < 8; ++i) {
        const int idx = tid + 256 * i, row = r0 + (idx >> 8), c4 = idx & 255;
        kv[i] = __builtin_nontemporal_load((const f32x4*)(p.cache_a_k + ((size_t)((j * 16 + b) * 2048 + row)) * 1024 + c4 * 4));
      }
#pragma unroll
      for (int i = 0; i < 8; ++i) {
        const int idx = tid + 256 * i, row = r0 + (idx >> 8), c4 = idx & 255;
        *reinterpret_cast<uint2*>(Kall + ((size_t)(MP + b * SKV + row)) * 1024 + c4 * 4) = pack4(kv[i][0], kv[i][1], kv[i][2], kv[i][3]);
      }
    } else {
      const int w = item - 4096;
      const int b = w >> 9, t = w & 511, rt = t >> 4, ct = t & 15;
      tconv_tile(p.cache_a_v + ((size_t)(j * 16 + b) * 2048) * 1024, 2048, 1024, 1024, Vts + (size_t)b * 1024 * VTS_LD,
                 VTS_LD, rt * 64, ct * 64, 0, (float*)smem);
    }
  }
}

DEV void conv_cache_c(const Params& p) {
  char* ws = wsp(p);
  bf16_t* KVB = (bf16_t*)(ws + C_KVB);
  bf16_t* Kf = (bf16_t*)(ws + B_K);
  const int tid = otid();
  for (int item = blockIdx.x; item < 1024 + 256; item += gridDim.x) {
    if (item < 1024) {
      const int b = item >> 6, r0 = (item & 63) * 32;
      f32x4 kv[8];
#pragma unroll
      for (int i = 0; i < 8; ++i) {
        const int idx = tid + 256 * i, row = r0 + (idx >> 6), c4 = idx & 63;
        kv[i] = __builtin_nontemporal_load((const f32x4*)(p.cache_c_kv + ((size_t)(b * 2048 + row)) * 256 + c4 * 4));
      }
#pragma unroll
      for (int i = 0; i < 8; ++i) {
        const int idx = tid + 256 * i, row = r0 + (idx >> 6), c4 = idx & 63;
        *reinterpret_cast<uint2*>(KVB + ((size_t)(MP + b * SKV + row)) * 256 + c4 * 4) = pack4(kv[i][0], kv[i][1], kv[i][2], kv[i][3]);
      }
    } else {
      const int w = item - 1024;
      const int b = w >> 4, r0 = (w & 15) * 128;
      f32x4 kv[8];
#pragma unroll
      for (int i = 0; i < 8; ++i) {
        const int idx = tid + 256 * i, row = r0 + (idx >> 4), c4 = idx & 15;
        kv[i] = __builtin_nontemporal_load((const f32x4*)(p.cache_c_kr + ((size_t)(b * 2048 + row)) * 64 + c4 * 4));
      }
#pragma unroll
      for (int i = 0; i < 8; ++i) {
        const int idx = tid + 256 * i, row = r0 + (idx >> 4), c4 = idx & 15;
        const uint2 pk = pack4(kv[i][0], kv[i][1], kv[i][2], kv[i][3]);
#pragma unroll
        for (int hh = 0; hh < 8; ++hh)
          *reinterpret_cast<uint2*>(Kf + ((size_t)(MP + b * SKV + row)) * 1536 + hh * 192 + 128 + c4 * 4) = pk;
      }
    }
  }
}

DEV void init_vx_rows(const Params& p) {
  char* ws = wsp(p);
  bf16_t* Vxp = (bf16_t*)(ws + M_VXP);
  bf16_t* Vxs = (bf16_t*)(ws + M_VXS);
  const int gt = blockIdx.x * 256 + otid(), gs = gridDim.x * 256;
  for (int e = gt; e < 16 * 16 * 4096; e += gs) {
    const int s = e >> 16, r = (e >> 12) & 15, t = e & 4095;
    Vxp[((size_t)(s * 272 + 256 + r)) * 4096 + t] = (r == 0) ? (bf16_t)0x3F80 : (bf16_t)0;
  }
  for (int e = gt; e < 64 * 16 * 32; e += gs) {
    const int s = e >> 9, r = (e >> 5) & 15, t = e & 31;
    Vxs[((size_t)(s * 272 + 256 + r)) * 32 + t] = (r == 0) ? (bf16_t)0x3F80 : (bf16_t)0;
  }
}

template <int N>
DEV void wait_vm() { asm volatile("s_waitcnt vmcnt(%0)" ::"n"(N) : "memory"); }

template <int NSUB, int DQK, bool KDB>
DEV void attn_core(const bf16_t* __restrict__ Qp, int ldq, int qrow, const bf16_t* __restrict__ Kp, int ldk,
                   const bf16_t* __restrict__ Vtp, int ldv, int nkeys, f32x4 (&O)[NSUB][8], char* smem) {
  constexpr int KW = NSUB * DQK, KS = DQK / 32, CT = KW / 32;
  constexpr int KBYTES = 64 * KW * 2;
  constexpr int NKL = KBYTES / 4096;
  char* sKb = smem;
  char* sV0 = smem + (KDB ? 2 : 1) * KBYTES;
  const int tid = otid(), lane = tid & 63;
  const int l15 = lane & 15, q4 = lane >> 4;
  bf16x8 qf[NSUB][KS];
#pragma unroll
  for (int s = 0; s < NSUB; ++s)
#pragma unroll
    for (int ks = 0; ks < KS; ++ks) qf[s][ks] = ld8(Qp + (size_t)qrow * ldq + s * DQK + ks * 32 + q4 * 8);
  float m[NSUB], lsum[NSUB];
#pragma unroll
  for (int s = 0; s < NSUB; ++s) {
    m[s] = -INFINITY; lsum[s] = 0.f;
#pragma unroll
    for (int dt = 0; dt < 8; ++dt) O[s][dt] = (f32x4){0.f, 0.f, 0.f, 0.f};
  }
  const int ntiles = (nkeys + 63) >> 6;
  int krow[NKL], kcol[NKL];
#pragma unroll
  for (int i = 0; i < NKL; ++i) {
    const int bq = tid * 16 + i * 4096;
    const int cbk = bq >> 13, bb = bq & 8191;
    krow[i] = (bb >> 10) * 8 + ((bb >> 7) & 7);
    kcol[i] = cbk * 64 + ((((bb >> 4) & 7) ^ ((krow[i] >> 1) & 7)) << 3);
  }
  auto stageK = [&](int kt) {
    char* kdst = sKb + (KDB ? (kt & 1) * KBYTES : 0);
#pragma unroll
    for (int i = 0; i < NKL; ++i) {
      const int key = min(kt * 64 + krow[i], nkeys - 1);
      __builtin_amdgcn_global_load_lds((const __attribute__((address_space(1))) void*)(Kp + (size_t)key * ldk + kcol[i]),
                                       (__attribute__((address_space(3))) void*)(kdst + tid * 16 + i * 4096), 16, 0, 0);
    }
  };
  auto stageV = [&](int kt) {
    char* dst = sV0 + (kt & 1) * 16384;
#pragma unroll
    for (int i = 0; i < 4; ++i) {
      const int bq = tid * 16 + i * 4096;
      const int R = (bq >> 10) * 8 + ((bq >> 7) & 7);
      const int C = ((((bq >> 4) & 7) ^ ((R >> 1) & 7))) << 3;
      __builtin_amdgcn_global_load_lds((const __attribute__((address_space(1))) void*)(Vtp + (size_t)R * ldv + kt * 64 + C),
                                       (__attribute__((address_space(3))) void*)(dst + bq), 16, 0, 0);
    }
  };
  __syncthreads();
  stageK(0);
  stageV(0);
  for (int kt = 0; kt < ntiles; ++kt) {
    const char* sV = sV0 + (kt & 1) * 16384;
    wait_vm<0>();
    __builtin_amdgcn_s_barrier();
    if (kt + 1 < ntiles) { stageV(kt + 1); if (KDB) stageK(kt + 1); }
    const char* sKc = sKb + (KDB ? (kt & 1) * KBYTES : 0);
    f32x4 st[NSUB][4];
#pragma unroll
    for (int s = 0; s < NSUB; ++s)
#pragma unroll
      for (int t4 = 0; t4 < 4; ++t4) {
        st[s][t4] = (f32x4){0.f, 0.f, 0.f, 0.f};
#pragma unroll
        for (int ks = 0; ks < KS; ++ks) {
          const int colk = s * DQK + ks * 32 + q4 * 8;
          const int off = (colk >> 6) * 8192 + gt_off(t4 * 16 + l15, (colk & 63) >> 3);
          st[s][t4] = mfma16(*reinterpret_cast<const bf16x8*>(sKc + off), qf[s][ks], st[s][t4]);
        }
      }
    if (!KDB) {
      WAIT_LGKM0();
      __builtin_amdgcn_s_barrier();
      if (kt + 1 < ntiles) stageK(kt + 1);
    }
    bf16x8 pf[NSUB][2];
    const bool tail = (kt == ntiles - 1) && ((nkeys & 63) != 0);
#pragma unroll
    for (int s = 0; s < NSUB; ++s) {
      if (tail) {
#pragma unroll
        for (int t4 = 0; t4 < 4; ++t4)
#pragma unroll
          for (int j = 0; j < 4; ++j)
            if (kt * 64 + t4 * 16 + q4 * 4 + j >= nkeys) st[s][t4][j] = -INFINITY;
      }
      float mx = st[s][0][0];
#pragma unroll
      for (int t4 = 0; t4 < 4; ++t4)
#pragma unroll
        for (int j = 0; j < 4; ++j) mx = fmaxf(mx, st[s][t4][j]);
      mx = xrow16_max(mx);
      float alpha = 1.f;
      if (__builtin_amdgcn_ballot_w64(mx - m[s] > 8.f) != 0ull) {
        const float mnew = fmaxf(m[s], mx);
        alpha = __builtin_amdgcn_exp2f(m[s] - mnew);
        m[s] = mnew;
        if (__builtin_amdgcn_ballot_w64(alpha != 1.f) != 0ull) {
#pragma unroll
          for (int dt = 0; dt < 8; ++dt) {
            O[s][dt][0] *= alpha; O[s][dt][1] *= alpha; O[s][dt][2] *= alpha; O[s][dt][3] *= alpha;
          }
        }
      }
      const float mcur = m[s];
      float ps = 0.f;
#pragma unroll
      for (int t4 = 0; t4 < 4; ++t4)
#pragma unroll
        for (int j = 0; j < 4; ++j) {
          const float pv = __builtin_amdgcn_exp2f(st[s][t4][j] - mcur);
          st[s][t4][j] = pv;
          ps += pv;
        }
      lsum[s] = lsum[s] * alpha + ps;
      pf[s][0] = packP(st[s][0], st[s][1]);
      pf[s][1] = packP(st[s][2], st[s][3]);
    }
#pragma unroll
    for (int dt = 0; dt < 8; ++dt)
#pragma unroll
      for (int kk = 0; kk < 2; ++kk) {
        const char* v0 = sV + gt_off(dt * 16 + l15, kk * 4 + (q4 >> 1)) + (q4 & 1) * 8;
        const char* v1 = sV + gt_off(dt * 16 + l15, kk * 4 + 2 + (q4 >> 1)) + (q4 & 1) * 8;
        const bf16x8 vf = ld2x4((const bf16_t*)v0, (const bf16_t*)v1);
#pragma unroll
        for (int s = 0; s < NSUB; ++s) O[s][dt] = mfma16(vf, pf[s][kk], O[s][dt]);
      }
  }
#pragma unroll
  for (int s = 0; s < NSUB; ++s) {
    float l = lsum[s];
    l = xrow16_sum(l);
    const float il = 1.f / l;
#pragma unroll
    for (int dt = 0; dt < 8; ++dt) {
      O[s][dt][0] *= il; O[s][dt][1] *= il; O[s][dt][2] *= il; O[s][dt][3] *= il;
    }
  }
}

DEV void attn_item_decode(int item, int& b, int& h, int& qrow0, int& nq, int& kvrow0, int& nkeys, bool& samp) {
  if (item >= 1024 && item < 1152) {
    const int i = item - 1024;
    samp = true; b = i >> 3; h = i & 7; qrow0 = MP + b * 32; nq = 32; kvrow0 = MP + b * SKV; nkeys = SKV;
  } else {
    const int i = item < 1024 ? item : item - 128;
    const int qb = 63 - (i >> 5), bh = i & 31;
    samp = false; b = bh >> 3; h = bh & 7; qrow0 = b * 4096 + qb * 64; nq = 64; kvrow0 = b * 4096; nkeys = (qb + 1) * 64;
  }
}
DEV int snake_item(int r) {
  const int G = gridDim.x;
  return (r & 1) ? (r * G + (G - 1 - (int)blockIdx.x)) : (r * G + (int)blockIdx.x);
}

DEV void diff_attn_phase(const Params& p, int j, float lam_init, char* smem) {
  char* ws = wsp(p);
  const bf16_t* Q = (const bf16_t*)(ws + B_Q);
  const bf16_t* Kall = (const bf16_t*)(ws + B_K);
  const bf16_t* Vtp = (const bf16_t*)(ws + B_VT);
  const bf16_t* Vts = Vtp + (size_t)4 * 1024 * 4096;
  bf16_t* att = (bf16_t*)(ws + B_ATT);
  const int lane = otid() & 63, wave = otid() >> 6;
  const int l15 = lane & 15, q4 = lane >> 4;
  const float* lv = p.a_lambda + j * 256;
  const float s1 = wave_sum(lv[lane] * lv[64 + lane], lane);
  const float s2 = wave_sum(lv[128 + lane] * lv[192 + lane], lane);
  const float lam = __expf(s1) - __expf(s2) + lam_init;
  const float* gs = p.g_a_sub + j * 128;
  for (int rnd = 0; rnd * (int)gridDim.x < 128 + 2048; ++rnd) {
    const int item = snake_item(rnd);
    if (item >= 128 + 2048) continue;
    int b, h, qrow0, nq, kvrow0, nkeys; bool samp;
    attn_item_decode(item, b, h, qrow0, nq, kvrow0, nkeys, samp);
    const int ql = wave * 16 + l15;
    const int qrow = min(ql, nq - 1);
    const bf16_t* Vb = samp ? (Vts + ((size_t)(b * 1024 + h * 128)) * VTS_LD) : (Vtp + ((size_t)(b * 1024 + h * 128)) * 4096);
    f32x4 O[2][8];
    attn_core<2, 64, true>(Q + (size_t)qrow0 * 1024 + h * 128, 1024, qrow, Kall + (size_t)kvrow0 * 1024 + h * 128, 1024, Vb,
                     samp ? VTS_LD : 4096, nkeys, O, smem);
    float ss = 0.f;
#pragma unroll
    for (int dt = 0; dt < 8; ++dt)
#pragma unroll
      for (int jj = 0; jj < 4; ++jj) {
        const float o = O[0][dt][jj] - lam * O[1][dt][jj];
        O[0][dt][jj] = o;
        ss += o * o;
      }
    ss = xrow16_sum(ss);
    const float r = rsqrtf(ss * (1.f / 128.f) + EPSN) * (1.f - lam_init);
    if (ql < nq) {
      bf16_t* o = att + (size_t)(qrow0 + ql) * 1024 + h * 128;
      f32x4 g4[8];
#pragma unroll
      for (int dt = 0; dt < 8; ++dt) g4[dt] = *(const f32x4*)(gs + dt * 16 + q4 * 4);
#pragma unroll
      for (int dt = 0; dt < 8; ++dt) {
        const int dv = dt * 16 + q4 * 4;
        *reinterpret_cast<uint2*>(o + dv) =
            pack4(O[0][dt][0] * r * g4[dt][0], O[0][dt][1] * r * g4[dt][1], O[0][dt][2] * r * g4[dt][2], O[0][dt][3] * r * g4[dt][3]);
      }
    }
  }
}

DEV void mla_attn_phase(const Params& p, char* smem) {
  char* ws = wsp(p);
  const bf16_t* Q = (const bf16_t*)(ws + B_Q);
  const bf16_t* Kf = (const bf16_t*)(ws + B_K);
  const bf16_t* Vtp = (const bf16_t*)(ws + B_VT);
  const bf16_t* Vts = Vtp + (size_t)4 * 1024 * 4096;
  bf16_t* att = (bf16_t*)(ws + B_ATT);
  const int lane = otid() & 63, wave = otid() >> 6;
  const int l15 = lane & 15, q4 = lane >> 4;
  for (int rnd = 0; rnd * (int)gridDim.x < 128 + 2048; ++rnd) {
    const int item = snake_item(rnd);
    if (item >= 128 + 2048) continue;
    int b, h, qrow0, nq, kvrow0, nkeys; bool samp;
    attn_item_decode(item, b, h, qrow0, nq, kvrow0, nkeys, samp);
    const int ql = wave * 16 + l15;
    const int qrow = min(ql, nq - 1);
    const bf16_t* Vb = samp ? (Vts + ((size_t)(b * 1024 + h * 128)) * VTS_LD) : (Vtp + ((size_t)(b * 1024 + h * 128)) * 4096);
    f32x4 O[1][8];
    attn_core<1, 192, false>(Q + (size_t)qrow0 * 1536 + h * 192, 1536, qrow, Kf + (size_t)kvrow0 * 1536 + h * 192, 1536, Vb,
                      samp ? VTS_LD : 4096, nkeys, O, smem);
    if (ql < nq) {
      bf16_t* o = att + (size_t)(qrow0 + ql) * 1024 + h * 128;
#pragma unroll
      for (int dt = 0; dt < 8; ++dt)
        *reinterpret_cast<uint2*>(o + dt * 16 + q4 * 4) = pack4(O[0][dt][0], O[0][dt][1], O[0][dt][2], O[0][dt][3]);
    }
  }
}

DEV float logsigmoidf_(float x) { return fminf(x, 0.f) - log1pf(__expf(-fabsf(x))); }

DEV void mlstm_gate_phase(const Params& p, char* smem) {
  char* ws = wsp(p);
  const float* Gt = (const float*)(ws + M_GT);
  float* U = (float*)(ws + M_U);
  float* MT = (float*)(ws + M_MT);
  float* BT = (float*)(ws + M_BT);
  float* WR = (float*)(ws + M_WR);
  float* MC = (float*)(ws + M_MC);
  float* DEC = (float*)(ws + M_DEC);
  float* sg = (float*)smem;
  float* su = sg + 64;
  float* sm = su + 64;
  float* sl = sm + 64;
  const int lane = otid() & 63, wave = otid() >> 6;
  for (int s = blockIdx.x; s < 80; s += gridDim.x) {
    const bool samp = s >= 16;
    const int s2 = samp ? s - 16 : s;
    const int b = s2 >> 2, h = s2 & 3;
    const int L = samp ? 32 : 64, NC = samp ? 1 : 64;
    const int row0 = samp ? (MP + b * 32) : (b * 4096);
    const int tok0 = samp ? (65536 + s2 * 32) : (s * 4096);
    const int ch0 = samp ? (1024 + s2) : (s * 64);
    const float bi = p.b_b_gates[h], bfg = p.b_b_gates[4 + h];
    __syncthreads();
    float igv[16], frv[16];
#pragma unroll
    for (int q = 0; q < 16; ++q) {
      const int c = wave + 4 * q;
      if (c < NC) {
        const int t = c * L + min(lane, L - 1);
        igv[q] = Gt[(size_t)(row0 + t) * 8 + h];
        frv[q] = Gt[(size_t)(row0 + t) * 8 + 4 + h];
      }
    }
#pragma unroll
    for (int q = 0; q < 16; ++q) {
      const int c = wave + 4 * q;
      if (c < NC) {
        const bool valid = lane < L;
        const int t = c * L + min(lane, L - 1);
        const float ig = igv[q] + bi;
        const float fr = frv[q] + bfg;
        float bb = valid ? logsigmoidf_(fr) : 0.f;
#pragma unroll
        for (int d = 1; d < 64; d <<= 1) {
          const float v = shfl_lane(bb, lane - d);
          if (lane >= d) bb += v;
        }
        const float u = valid ? (ig - bb) : -INFINITY;
        float pm = u;
#pragma unroll
        for (int d = 1; d < 64; d <<= 1) {
          const float v = shfl_lane(pm, lane - d);
          if (lane >= d) pm = fmaxf(pm, v);
        }
        const float g = __int_as_float(__builtin_amdgcn_readlane(__float_as_int(bb), L - 1));
        const float um = __int_as_float(__builtin_amdgcn_readlane(__float_as_int(pm), L - 1));
        if (valid) {
          BT[tok0 + t] = bb;
          U[tok0 + t] = u;
        }
        igv[q] = u;
        frv[q] = pm;
        if (lane == 0) { sg[c] = g; su[c] = um; }
      }
    }
    __syncthreads();
    if (otid() == 0) {
      float m = samp ? p.state_b_m[s2] : 0.f;
      for (int c = 0; c < NC; ++c) {
        sm[c] = m;
        const float ml = fmaxf(m, su[c]);
        sl[c] = ml;
        m = sg[c] + ml;
      }
      if (samp) p.out[O_BMS + s2] = m; else p.out[O_BMP + s] = m;
    }
    __syncthreads();
#pragma unroll
    for (int q = 0; q < 16; ++q) {
      const int c = wave + 4 * q;
      if (c < NC) {
        const float mc = sm[c], ml = sl[c];
        if (lane < L) {
          const int t = c * L + lane;
          MT[tok0 + t] = fmaxf(mc, frv[q]);
          WR[tok0 + t] = __expf(igv[q] - ml);
        }
        if (lane == 0) { MC[ch0 + c] = mc; DEC[ch0 + c] = __expf(mc - ml); }
      }
    }
  }
  __syncthreads();
}

template <int KS>
DEV void mlstm_state_item(const Params& p, int s2, bool samp, int dt) {
  char* ws = wsp(p);
  const int lane = otid() & 63, wave = otid() >> 6;
  const int l15 = lane & 15, q4 = lane >> 4;
  constexpr int L = KS * 32;
  const int NC = samp ? 1 : 64;
  const int ldt = samp ? 32 : 4096;
  const bf16_t* Vx = samp ? ((const bf16_t*)(ws + M_VXS) + ((size_t)(s2 * 272 + dt * 16)) * 32)
                          : ((const bf16_t*)(ws + M_VXP) + ((size_t)(s2 * 272 + dt * 16)) * 4096);
  const bf16_t* Kt = samp ? ((const bf16_t*)(ws + M_KT) + (size_t)16 * 128 * 4096 + (size_t)s2 * 128 * 32)
                          : ((const bf16_t*)(ws + M_KT) + (size_t)s2 * 128 * 4096);
  const float* WR = (const float*)(ws + M_WR) + (samp ? (65536 + s2 * 32) : (s2 * 4096));
  const float* DEC = (const float*)(ws + M_DEC) + (samp ? (1024 + s2) : (s2 * 64));
  bf16_t* CT = (bf16_t*)(ws + M_CT) + (size_t)(samp ? (1024 + s2) : (s2 * 64)) * 272 * 128;
  f32x4 acc[2];
#pragma unroll
  for (int nt = 0; nt < 2; ++nt) {
    const int dq = wave * 32 + nt * 16 + l15;
#pragma unroll
    for (int j = 0; j < 4; ++j) {
      float v = 0.f;
      if (samp) {
        if (dt < 16) v = p.state_b_c[((size_t)(s2 * 128 + dq)) * 256 + dt * 16 + q4 * 4 + j];
        else if (q4 == 0 && j == 0) v = p.state_b_n[s2 * 128 + dq];
      }
      acc[nt][j] = v;
    }
  }
  bf16x8 vr[KS], kb[KS][2];
  f32x4 w0[KS], w1[KS];
  float dec;
  auto load_ops = [&](int c, bf16x8 (&vr_)[KS], bf16x8 (&kb_)[KS][2], f32x4 (&w0_)[KS], f32x4 (&w1_)[KS], float& dec_) {
    dec_ = DEC[c];
#pragma unroll
    for (int ks = 0; ks < KS; ++ks) {
      const int t0 = c * L + ks * 32 + q4 * 8;
      vr_[ks] = ld8(Vx + (size_t)l15 * ldt + t0);
      w0_[ks] = *(const f32x4*)(WR + t0);
      w1_[ks] = *(const f32x4*)(WR + t0 + 4);
#pragma unroll
      for (int nt = 0; nt < 2; ++nt) kb_[ks][nt] = ld8(Kt + (size_t)(wave * 32 + nt * 16 + l15) * ldt + t0);
    }
  };
  load_ops(0, vr, kb, w0, w1, dec);
  for (int c = 0; c < NC; ++c) {
    bf16x8 vrn[KS], kbn[KS][2];
    f32x4 w0n[KS], w1n[KS];
    float decn = 0.f;
    if (c + 1 < NC) load_ops(c + 1, vrn, kbn, w0n, w1n, decn);
#pragma unroll
    for (int nt = 0; nt < 2; ++nt)
#pragma unroll
      for (int j = 0; j < 4; ++j)
        CT[((size_t)c * 272 + dt * 16 + q4 * 4 + j) * 128 + wave * 32 + nt * 16 + l15] = f2bf(acc[nt][j]);
#pragma unroll
    for (int nt = 0; nt < 2; ++nt) { acc[nt][0] *= dec; acc[nt][1] *= dec; acc[nt][2] *= dec; acc[nt][3] *= dec; }
#pragma unroll
    for (int ks = 0; ks < KS; ++ks) {
      u32x4 vp;
      vp[0] = pack2(bf2f((bf16_t)vr[ks][0]) * w0[ks][0], bf2f((bf16_t)vr[ks][1]) * w0[ks][1]);
      vp[1] = pack2(bf2f((bf16_t)vr[ks][2]) * w0[ks][2], bf2f((bf16_t)vr[ks][3]) * w0[ks][3]);
      vp[2] = pack2(bf2f((bf16_t)vr[ks][4]) * w1[ks][0], bf2f((bf16_t)vr[ks][5]) * w1[ks][1]);
      vp[3] = pack2(bf2f((bf16_t)vr[ks][6]) * w1[ks][2], bf2f((bf16_t)vr[ks][7]) * w1[ks][3]);
      const bf16x8 va = __builtin_bit_cast(bf16x8, vp);
#pragma unroll
      for (int nt = 0; nt < 2; ++nt) acc[nt] = mfma16(va, kb[ks][nt], acc[nt]);
    }
    if (c + 1 < NC) {
      dec = decn;
#pragma unroll
      for (int ks = 0; ks < KS; ++ks) {
        vr[ks] = vrn[ks]; w0[ks] = w0n[ks]; w1[ks] = w1n[ks]; kb[ks][0] = kbn[ks][0]; kb[ks][1] = kbn[ks][1];
      }
    }
  }
  float* oc = samp ? (p.out + O_BCS + (size_t)s2 * 128 * 256) : (p.out + O_BCP + (size_t)s2 * 128 * 256);
  float* on = samp ? (p.out + O_BNS + (size_t)s2 * 128) : (p.out + O_BNP + (size_t)s2 * 128);
#pragma unroll
  for (int nt = 0; nt < 2; ++nt) {
    const int dq = wave * 32 + nt * 16 + l15;
    if (dt < 16) {
      float4 v; v.x = acc[nt][0]; v.y = acc[nt][1]; v.z = acc[nt][2]; v.w = acc[nt][3];
      *(float4*)(oc + (size_t)dq * 256 + dt * 16 + q4 * 4) = v;
    } else if (q4 == 0) {
      on[dq] = acc[nt][0];
    }
  }
}

DEV void mlstm_state_phase(const Params& p) {
  for (int item = blockIdx.x; item < 272 + 1088; item += gridDim.x) {
    if (item < 272) mlstm_state_item<2>(p, item / 17, false, item % 17);
    else { const int w = item - 272; mlstm_state_item<1>(p, w / 17, true, w % 17); }
  }
}

DEV void mlstm_out_phase(const Params& p, char* smem) {
  char* ws = wsp(p);
  const bf16_t* Qb = (const bf16_t*)(ws + B_Q);
  const bf16_t* Kb = (const bf16_t*)(ws + B_K);
  const bf16_t* Opre = (const bf16_t*)(ws + M_OPRE);
  bf16_t* Hn = (bf16_t*)(ws + B_ATT);
  bf16_t* sK = (bf16_t*)smem;
  bf16_t* sV = sK + 64 * 136;
  const int tid = otid(), lane = tid & 63, wave = tid >> 6;
  const int l15 = lane & 15, q4 = lane >> 4;
  for (int item = blockIdx.x; item < 1024 + 64; item += gridDim.x) {
    const bool samp = item >= 1024;
    const int s2 = samp ? item - 1024 : (item >> 6);
    const int c = samp ? 0 : (item & 63);
    const int b = s2 >> 2, h = s2 & 3;
    const int L = samp ? 32 : 64;
    const int rowbase = samp ? (MP + b * 32) : (b * 4096 + c * 64);
    const int tok0 = samp ? (65536 + s2 * 32) : (s2 * 4096 + c * 64);
    const int chi = samp ? (1024 + s2) : (s2 * 64 + c);
    const bf16_t* Vx = samp ? ((const bf16_t*)(ws + M_VXS) + (size_t)s2 * 272 * 32)
                            : ((const bf16_t*)(ws + M_VXP) + (size_t)s2 * 272 * 4096 + c * 64);
    const int ldt = samp ? 32 : 4096;
    const bf16_t* CT = (const bf16_t*)(ws + M_CT) + (size_t)chi * 272 * 128;
    const float* U = (const float*)(ws + M_U) + tok0;
    const float* MT = (const float*)(ws + M_MT) + tok0;
    const float* BT = (const float*)(ws + M_BT) + tok0;
    const float mc = ((const float*)(ws + M_MC))[chi];
    const int tl = wave * 16 + l15;
    const int tcl = min(tl, L - 1);
    __syncthreads();
#pragma unroll
    for (int i = 0; i < 4; ++i) {
      const int cc = tid + i * 256, r = cc >> 4, kc = cc & 15;
      *reinterpret_cast<uint4*>(sK + r * 136 + kc * 8) =
          *reinterpret_cast<const uint4*>(Kb + (size_t)(rowbase + min(r, L - 1)) * 512 + h * 128 + kc * 8);
    }
#pragma unroll
    for (int i = 0; i < 9; ++i) {
      const int cc = tid + i * 256;
      if (cc < 2176) {
        const int r = cc >> 3, kc = cc & 7;
        uint4 v = make_uint4(0, 0, 0, 0);
        if (kc * 8 < L) v = *reinterpret_cast<const uint4*>(Vx + (size_t)r * ldt + kc * 8);
        *reinterpret_cast<uint4*>(sV + r * 72 + kc * 8) = v;
      }
    }
    bf16x8 qf[4];
#pragma unroll
    for (int ks = 0; ks < 4; ++ks) qf[ks] = ld8(Qb + (size_t)(rowbase + tcl) * 512 + h * 128 + ks * 32 + q4 * 8);
    const float Mt_t = MT[tcl], bt_t = BT[tcl];
    const float a_t = __expf(mc - Mt_t);
    __syncthreads();
    bf16x8 pf[2];
    {
      f32x4 st[4];
#pragma unroll
      for (int t4 = 0; t4 < 4; ++t4) {
        st[t4] = (f32x4){0.f, 0.f, 0.f, 0.f};
#pragma unroll
        for (int ks = 0; ks < 4; ++ks) st[t4] = mfma16(ld8(sK + (t4 * 16 + l15) * 136 + ks * 32 + q4 * 8), qf[ks], st[t4]);
        const float4 u4 = *(const float4*)(U + t4 * 16 + q4 * 4);
        const int sb = t4 * 16 + q4 * 4;
        st[t4][0] = (sb + 0 <= tl && sb + 0 < L) ? st[t4][0] * __expf(u4.x - Mt_t) : 0.f;
        st[t4][1] = (sb + 1 <= tl && sb + 1 < L) ? st[t4][1] * __expf(u4.y - Mt_t) : 0.f;
        st[t4][2] = (sb + 2 <= tl && sb + 2 < L) ? st[t4][2] * __expf(u4.z - Mt_t) : 0.f;
        st[t4][3] = (sb + 3 <= tl && sb + 3 < L) ? st[t4][3] * __expf(u4.w - Mt_t) : 0.f;
      }
      pf[0] = packP(st[0], st[1]);
      pf[1] = packP(st[2], st[3]);
    }
    f32x4 acc[17];
#pragma unroll
    for (int dt = 0; dt < 17; ++dt) {
      acc[dt] = (f32x4){0.f, 0.f, 0.f, 0.f};
#pragma unroll
      for (int ks = 0; ks < 4; ++ks)
        acc[dt] = mfma16(ld8(CT + (size_t)(dt * 16 + l15) * 128 + ks * 32 + q4 * 8), qf[ks], acc[dt]);
      acc[dt][0] *= a_t; acc[dt][1] *= a_t; acc[dt][2] *= a_t; acc[dt][3] *= a_t;
#pragma unroll
      for (int kk = 0; kk < 2; ++kk) {
        const bf16_t* vb = sV + (dt * 16 + l15) * 72 + kk * 32 + q4 * 4;
        acc[dt] = mfma16(ld2x4(vb, vb + 16), pf[kk], acc[dt]);
      }
    }
    const float den = shfl_lane(acc[16][0], l15);
    const float dn = fmaxf(fabsf(den), __expf(-(bt_t + Mt_t)));
    const float idn = 1.f / dn;
    float ss = 0.f;
#pragma unroll
    for (int dt = 0; dt < 16; ++dt)
#pragma unroll
      for (int j = 0; j < 4; ++j) {
        const float hv = acc[dt][j] * idn;
        acc[dt][j] = hv;
        ss += hv * hv;
      }
    ss = xrow16_sum(ss);
    const float r = rsqrtf(ss * (1.f / 256.f) + EPSN);
    if (tl < L) {
      const size_t ro = (size_t)(rowbase + tl) * 1024 + h * 256;
      const float* gbo = p.g_b_out + h * 256;
      f32x4 g4[16];
      uint32_t obx[16], oby[16];
#pragma unroll
      for (int dt = 0; dt < 16; ++dt) {
        const int dv = dt * 16 + q4 * 4;
        g4[dt] = *(const f32x4*)(gbo + dv);
        obx[dt] = *reinterpret_cast<const uint32_t*>(Opre + ro + dv);
        oby[dt] = *reinterpret_cast<const uint32_t*>(Opre + ro + dv + 2);
      }
#pragma unroll
      for (int dt = 0; dt < 16; ++dt) {
        const int dv = dt * 16 + q4 * 4;
        const float o0 = bf2f((bf16_t)(obx[dt] & 0xffff)), o1 = bf2f((bf16_t)(obx[dt] >> 16));
        const float o2 = bf2f((bf16_t)(oby[dt] & 0xffff)), o3 = bf2f((bf16_t)(oby[dt] >> 16));
        *reinterpret_cast<uint2*>(Hn + ro + dv) =
            pack4(acc[dt][0] * r * g4[dt][0] * o0, acc[dt][1] * r * g4[dt][1] * o1, acc[dt][2] * r * g4[dt][2] * o2, acc[dt][3] * r * g4[dt][3] * o3);
      }
    }
  }
  __syncthreads();
}

#define XB_TMO      128
#define XB_XCNT(j)  (256  + 64 * (j))
#define XB_XSUB(j)  (1280 + 64 * (j))
#define XB_XGEN(j)  (2304 + 64 * (j))
#define XB_TOP      3328
#define XB_TOPGEN   3392
#define XCD_BAR_WORDS 3456
#define XB_SPIN_CAP (1u << 20)
#define LAS __attribute__((address_space(3)))
DEV unsigned xb_ld(unsigned* p) { return __hip_atomic_load(p, __ATOMIC_RELAXED, __HIP_MEMORY_SCOPE_AGENT); }
DEV unsigned xb_add(unsigned* p, unsigned v) { return __hip_atomic_fetch_add(p, v, __ATOMIC_RELAXED, __HIP_MEMORY_SCOPE_AGENT); }
DEV unsigned xb_xcc_id() { return (unsigned)__builtin_amdgcn_s_getreg((3 << 11) | 20) & 0xFu; }
#define XB_SPIN(cond, bar) do { unsigned _sp = 0; while (cond) { __builtin_amdgcn_s_sleep(1); \
    if ((++_sp & 255u) == 0u) { if (xb_ld(&(bar)[XB_TMO])) break; if (_sp > XB_SPIN_CAP) { atomicAdd(&(bar)[XB_TMO], 1u); break; } } } } while (0)

DEV void xcd_barrier_complete(unsigned* bar, unsigned x, unsigned& nloc, unsigned& nx) {
  const unsigned G = gridDim.x;
  unsigned sum, cnt, mine, sp = 0u;
  for (;;) {
    sum = 0u; cnt = 0u; mine = 0u;
#pragma unroll
    for (unsigned j = 0; j < 16; ++j) {
      const unsigned c = xb_ld(&bar[XB_XCNT(j)]);
      sum += c; cnt += (c > 0u) ? 1u : 0u; mine = (j == x) ? c : mine;
    }
    if (sum == G) break;
    __builtin_amdgcn_s_sleep(1);
    if ((++sp & 255u) == 0u) { if (xb_ld(&bar[XB_TMO])) break; if (sp > XB_SPIN_CAP) { atomicAdd(&bar[XB_TMO], 1u); break; } }
  }
  nloc = mine > 0u ? mine : 1u; nx = cnt > 0u ? cnt : 1u;
}
DEV void gbar_post(const Params& p) {
  if (threadIdx.x == 0) {
    unsigned* bar = (unsigned*)(wsp(p) + B_BAR);
    (void)xb_add(&bar[XB_XCNT(xb_xcc_id())], 1u);
  }
}
DEV void gbar(const Params& p, volatile LAS unsigned* st) {
  asm volatile("s_waitcnt vmcnt(0)" ::: "memory");
  __syncthreads();
  if (threadIdx.x == 0) {
    unsigned* bar = (unsigned*)(wsp(p) + B_BAR);
    const unsigned x = xb_xcc_id();
    __builtin_amdgcn_s_waitcnt(0);
    unsigned nloc = st[0], nx = st[1];
    if (nloc == 0u) { xcd_barrier_complete(bar, x, nloc, nx); st[0] = nloc; st[1] = nx; }
    const unsigned old = xb_add(&bar[XB_XSUB(x)], 1u);
    const unsigned gen = old / nloc;
    if (old + 1u == (gen + 1u) * nloc) {
      __builtin_amdgcn_fence(__ATOMIC_RELEASE, "agent");
      asm volatile("s_waitcnt vmcnt(0)" ::: "memory");
      const unsigned og = xb_add(&bar[XB_TOP], 1u);
      const unsigned tg = og / nx;
      if (og + 1u == (tg + 1u) * nx) xb_add(&bar[XB_TOPGEN], 1u);
      else XB_SPIN(xb_ld(&bar[XB_TOPGEN]) == tg, bar);
      __builtin_amdgcn_fence(__ATOMIC_ACQUIRE, "agent");
      xb_add(&bar[XB_XGEN(x)], 1u);
      asm volatile("s_waitcnt vmcnt(0)" ::: "memory");
    } else {
      XB_SPIN(xb_ld(&bar[XB_XGEN(x)]) == gen, bar);
      __builtin_amdgcn_fence(__ATOMIC_ACQUIRE, "agent");
      asm volatile("s_waitcnt vmcnt(0)" ::: "memory");
    }
  }
  __syncthreads();
}

__global__ void __launch_bounds__(256, 2) mega_kernel(Params kp) {
  cg::grid_group grid = cg::this_grid();
  __shared__ __attribute__((aligned(16))) char smem[SMEM_BYTES];
  __shared__ Params p;
  __shared__ uint4 xb_words;
  if (threadIdx.x == 0) { p = kp; xb_words = make_uint4(0u, 0u, 0u, 0u); }
  __syncthreads();
  if (blockIdx.x == 0) {
    unsigned* bar = (unsigned*)(wsp(p) + B_BAR);
    for (int i = threadIdx.x; i < XCD_BAR_WORDS; i += 256) bar[i] = 0u;
  }
  phase0(p, smem);
  grid.sync();
  gbar_post(p);
#define GSYNC() gbar(p, (volatile LAS unsigned*)&xb_words)

  for (int layer = 0; layer < 4; ++layer) {
    const int kind = layer % 3, j = layer / 3;
    {
      char* ws = wsp(p);
      norm_mod_phase((float*)(ws + B_X), p.g_norm1 + layer * 1024, (const float*)(ws + B_MOD) + (size_t)layer * 20 * 6144, 0, 1024, (bf16_t*)(ws + B_H),
                     (const float*)(ws + B_PART), layer > 0 ? 11 : 0);
    }
    if (kind == 0) { if (j == 0) conv_cache_a(p, 0, smem); }
    else if (kind == 1) init_vx_rows(p);
    else conv_cache_c(p);
    GSYNC();
    if (kind == 0) {
      {
        char* ws = wsp(p);
        float* out = p.out;
        EpiQKV e;
        e.Q = (bf16_t*)(ws + B_Q); e.Kall = (bf16_t*)(ws + B_K); e.Vtp = (bf16_t*)(ws + B_VT); e.Vts = e.Vtp + (size_t)4 * 1024 * 4096;
        e.ropa = (const float2*)(ws + B_ROPA);
        e.akp = out + O_AKP + (size_t)j * MP * 1024; e.aks = out + O_AKS + (size_t)j * MS * 1024;
        e.avp = out + O_AVP + (size_t)j * MP * 1024; e.avs = out + O_AVS + (size_t)j * MS * 1024;
        gemm_wide_phase<true>((const bf16_t*)(ws + B_H), 1024, (const bf16_t*)(ws + W_QKV) + (size_t)j * 3072 * 1024, 1024, MA / 128, 12, 1024, e, smem);
      }
      GSYNC();
      diff_attn_phase(p, j, j == 0 ? p.lam_init0 : p.lam_init3, smem);
      GSYNC();
      {
        char* ws = wsp(p);
        EpiRes r; r.x = (float*)(ws + B_X); r.gate = (const float*)(ws + B_MOD) + (size_t)layer * 20 * 6144 + 2048;
        gemm_res_phase((const bf16_t*)(ws + B_ATT), 1024, (const bf16_t*)(ws + W_AO) + (size_t)j * 1024 * 1024, 1024, 1024, 16, r, (float*)(ws + B_PART), smem);
      }
      GSYNC();
    } else if (kind == 1) {
      {
        char* ws = wsp(p);
        EpiBin e;
        e.Qb = (bf16_t*)(ws + B_Q); e.Kb = (bf16_t*)(ws + B_K); e.Ktp = (bf16_t*)(ws + M_KT); e.Kts = e.Ktp + (size_t)16 * 128 * 4096;
        e.Vxp = (bf16_t*)(ws + M_VXP); e.Vxs = (bf16_t*)(ws + M_VXS); e.Opre = (bf16_t*)(ws + M_OPRE);
        e.Gt = (float*)(ws + M_GT);
        gemm_wide_phase<false>((const bf16_t*)(ws + B_H), 1024, (const bf16_t*)(ws + W_BIN), 1024, MA / 128, 13, 1024, e, smem);
      }
      GSYNC();
      mlstm_gate_phase(p, smem);
      GSYNC();
      mlstm_state_phase(p);
      GSYNC();
      mlstm_out_phase(p, smem);
      GSYNC();
      {
        char* ws = wsp(p);
        EpiRes r; r.x = (float*)(ws + B_X); r.gate = (const float*)(ws + B_MOD) + (size_t)layer * 20 * 6144 + 2048;
        gemm_res_phase((const bf16_t*)(ws + B_ATT), 1024, (const bf16_t*)(ws + W_BOUT), 1024, 1024, 16, r, (float*)(ws + B_PART), smem);
      }
      GSYNC();
    } else {
      {
        char* ws = wsp(p);
        EpiF32 e; e.raw = (float*)(ws + C_RAW);
        gemm_phase((const bf16_t*)(ws + B_H), 1024, (const bf16_t*)(ws + W_CD), 1024, MA / 128, 6, 1024, e, smem);
      }
      GSYNC();
      mla_norm_phase(p);
      GSYNC();
      {
        char* ws = wsp(p);
        EpiUQ eq; eq.Qc = (bf16_t*)(ws + B_Q); eq.ropc = (const float2*)(ws + B_ROPC);
        gemm_phase((const bf16_t*)(ws + C_QN), 384, (const bf16_t*)(ws + W_UQ), 384, MA / 128, 12, 384, eq, smem);
      }
      {
        char* ws = wsp(p);
        EpiUKV ek; ek.Kf = (bf16_t*)(ws + B_K); ek.Vtp = (bf16_t*)(ws + B_VT); ek.Vts = ek.Vtp + (size_t)4 * 1024 * 4096;
        gemm_phase((const bf16_t*)(ws + C_KVB), 256, (const bf16_t*)(ws + W_UKV), 256, KVROWS / 128, 16, 256, ek, smem);
      }
      GSYNC();
      mla_attn_phase(p, smem);
      GSYNC();
      {
        char* ws = wsp(p);
        EpiRes r; r.x = (float*)(ws + B_X); r.gate = (const float*)(ws + B_MOD) + (size_t)layer * 20 * 6144 + 2048;
        gemm_res_phase((const bf16_t*)(ws + B_ATT), 1024, (const bf16_t*)(ws + W_CO), 1024, 1024, 16, r, (float*)(ws + B_PART), smem);
      }
      GSYNC();
    }
    {
      char* ws = wsp(p);
      norm_mod_phase((float*)(ws + B_X), p.g_norm2 + layer * 1024, (const float*)(ws + B_MOD) + (size_t)layer * 20 * 6144, 3072, 4096, (bf16_t*)(ws + B_H),
                     (const float*)(ws + B_PART), 16);
    }
    GSYNC();
    {
      char* ws = wsp(p);
      EpiSwiglu e; e.act = (bf16_t*)(ws + B_ACT);
      const bool side = (layer == 2);
      const bool first = blockIdx.x >= (gridDim.x >> 1);
      if (side && first) conv_cache_a(p, 1, smem);
      gemm_wide_phase<false>((const bf16_t*)(ws + B_H), 1024, (const bf16_t*)(ws + W_FIN) + (size_t)layer * 5632 * 1024, 1024, MA / 128, 22, 1024, e, smem);
      if (side && !first) conv_cache_a(p, 1, smem);
    }
    GSYNC();
    {
      char* ws = wsp(p);
      EpiRes r; r.x = (float*)(ws + B_X); r.gate = (const float*)(ws + B_MOD) + (size_t)layer * 20 * 6144 + 5120;
      gemm_res_phase((const bf16_t*)(ws + B_ACT), 2816, (const bf16_t*)(ws + W_FOUT) + (size_t)layer * 1024 * 2816, 2816, 2816, 11, r, (float*)(ws + B_PART), smem);
    }
    GSYNC();
  }
  {
    char* ws = wsp(p);
    final_norm_phase((const float*)(ws + B_X), p.g_final, p.out, (const float*)(ws + B_PART), 11);
  }
}

extern "C" void kernel_launch(void* const* d_in, const int* in_sizes, int n_in, void* d_out, int out_size, void* d_ws,
                              size_t ws_size, hipStream_t stream) {
  static int grid_blocks = 0;
  if (!grid_blocks) {
    int dev = 0, cus = 0, per_cu = 0;
    hipGetDevice(&dev);
    hipDeviceGetAttribute(&cus, hipDeviceAttributeMultiprocessorCount, dev);
    hipOccupancyMaxActiveBlocksPerMultiprocessor(&per_cu, mega_kernel, 256, 0);
    if (per_cu > 2) per_cu = 2;
    if (per_cu < 1) per_cu = 1;
    grid_blocks = (cus * per_cu) & ~7;
    if (grid_blocks < 8) grid_blocks = 8;
  }
  Params p{};
  const float* const* in = (const float* const*)d_in;
  p.x_prompt = in[0]; p.x_sample = in[1]; p.c_prompt = in[2]; p.c_sample = in[3]; p.cache_a_k = in[4];
  p.cache_a_v = in[5]; p.state_b_c = in[6]; p.state_b_n = in[7]; p.state_b_m = in[8]; p.cache_c_kv = in[9];
  p.cache_c_kr = in[10]; p.w_ada = in[11]; p.b_ada = in[12]; p.g_norm1 = in[13]; p.g_norm2 = in[14];
  p.w_a_qkv = in[15]; p.a_lambda = in[16]; p.g_a_sub = in[17]; p.w_a_o = in[18]; p.w_b_in = in[19];
  p.b_b_gates = in[20]; p.g_b_out = in[21]; p.w_b_out = in[22]; p.w_c_dq = in[23]; p.g_c_q = in[24];
  p.w_c_uq = in[25]; p.w_c_dkv = in[26]; p.g_c_kv = in[27]; p.w_c_ukv = in[28]; p.w_c_o = in[29];
  p.w_ffn_in = in[30]; p.w_ffn_out = in[31]; p.g_final = in[32];
  p.out = (float*)d_out;
  p.ws = (char*)d_ws;
  p.lam_init0 = (float)(0.8 - 0.6 * exp(-0.3 * 0.0));
  p.lam_init3 = (float)(0.8 - 0.6 * exp(-0.3 * 3.0));
  void* args[] = {&p};
  hipError_t e = hipLaunchCooperativeKernel((void*)mega_kernel, dim3(grid_blocks), dim3(256), args, 0, stream);
  if (e != hipSuccess) fprintf(stderr, "cooperative launch failed: %s (grid %d)\n", hipGetErrorString(e), grid_blocks);
}
```

```cpp
#include <hip/hip_runtime.h>
#include <hip/hip_cooperative_groups.h>
#include <stdint.h>
#include <math.h>
#include <cstdio>
namespace cg = cooperative_groups;

#define DEV __device__ __forceinline__

typedef unsigned short bf16_t;
typedef __attribute__((ext_vector_type(8))) short bf16x8;
typedef __attribute__((ext_vector_type(4))) short bf16x4;
typedef __attribute__((ext_vector_type(4))) float f32x4;
typedef __attribute__((ext_vector_type(4))) unsigned int u32x4;

constexpr int MP = 16384;
constexpr int MS = 512;
constexpr int MA = MP + MS;
constexpr int SKV = 2080;
constexpr int KVROWS = MP + 16 * SKV;
constexpr int VTS_LD = 2112;
constexpr float EPSN = 1e-6f;
constexpr float LOG2E = 1.4426950408889634f;
constexpr float LOG2_THETA = 18.931568569324174f;

constexpr size_t O_YP = 0;
constexpr size_t O_YS = O_YP + (size_t)MP * 1024;
constexpr size_t O_AKP = O_YS + (size_t)MS * 1024;
constexpr size_t O_AVP = O_AKP + (size_t)2 * MP * 1024;
constexpr size_t O_BCP = O_AVP + (size_t)2 * MP * 1024;
constexpr size_t O_BNP = O_BCP + (size_t)16 * 128 * 256;
constexpr size_t O_BMP = O_BNP + (size_t)16 * 128;
constexpr size_t O_CKVP = O_BMP + 16;
constexpr size_t O_CKRP = O_CKVP + (size_t)MP * 256;
constexpr size_t O_AKS = O_CKRP + (size_t)MP * 64;
constexpr size_t O_AVS = O_AKS + (size_t)2 * MS * 1024;
constexpr size_t O_BCS = O_AVS + (size_t)2 * MS * 1024;
constexpr size_t O_BNS = O_BCS + (size_t)64 * 128 * 256;
constexpr size_t O_BMS = O_BNS + (size_t)64 * 128;
constexpr size_t O_CKVS = O_BMS + 64;
constexpr size_t O_CKRS = O_CKVS + (size_t)MS * 256;

constexpr size_t AL(size_t x) { return (x + 255) & ~(size_t)255; }
constexpr size_t W_QKV = 0;
constexpr size_t W_AO = W_QKV + AL((size_t)2 * 3072 * 1024 * 2);
constexpr size_t W_BIN = W_AO + AL((size_t)2 * 1024 * 1024 * 2);
constexpr size_t W_BOUT = W_BIN + AL((size_t)3200 * 1024 * 2);
constexpr size_t W_CD = W_BOUT + AL((size_t)1024 * 1024 * 2);
constexpr size_t W_UQ = W_CD + AL((size_t)768 * 1024 * 2);
constexpr size_t W_UKV = W_UQ + AL((size_t)1536 * 384 * 2);
constexpr size_t W_CO = W_UKV + AL((size_t)2048 * 256 * 2);
constexpr size_t W_FIN = W_CO + AL((size_t)1024 * 1024 * 2);
constexpr size_t W_FOUT = W_FIN + AL((size_t)4 * 5632 * 1024 * 2);
constexpr size_t B_MOD = W_FOUT + AL((size_t)4 * 1024 * 2816 * 2);
constexpr size_t B_ROPA = B_MOD + AL((size_t)4 * 20 * 6144 * 4);
constexpr size_t B_ROPC = B_ROPA + AL((size_t)4096 * 8 * 8);
constexpr size_t B_X = B_ROPC + AL((size_t)4096 * 32 * 8);
constexpr size_t B_H = B_X + AL((size_t)MA * 1024 * 4);
constexpr size_t B_ACT = B_H + AL((size_t)MA * 1024 * 2);
constexpr size_t B_Q = B_ACT + AL((size_t)MA * 2816 * 2);
constexpr size_t B_K = B_Q + AL((size_t)MA * 1536 * 2);
constexpr size_t B_VT = B_K + AL((size_t)KVROWS * 1536 * 2);
constexpr size_t VT_BYTES = AL((size_t)4 * 1024 * 4096 * 2 + (size_t)16 * 1024 * VTS_LD * 2);
constexpr size_t B_ATT = B_VT + VT_BYTES;
constexpr size_t B_BAR = B_ATT + AL((size_t)MA * 1024 * 2);
constexpr size_t B_PART = B_BAR + 16384;
constexpr size_t WS_TOTAL = B_PART + (size_t)16 * MS * 1024 * 4;
constexpr size_t C_RAW = B_ACT;
constexpr size_t C_QN = C_RAW + AL((size_t)MA * 768 * 4);
constexpr size_t C_KVB = C_QN + AL((size_t)MA * 384 * 2);
static_assert(C_KVB + (size_t)KVROWS * 256 * 2 <= B_Q, "mla alias");
constexpr size_t M_CT = B_ACT;
static_assert((size_t)1088 * 272 * 128 * 2 <= B_Q - B_ACT, "ct alias");
constexpr size_t M_KT = B_K + AL((size_t)MA * 512 * 2);
constexpr size_t M_OPRE = M_KT + AL((size_t)16 * 128 * 4096 * 2 + (size_t)64 * 128 * 32 * 2);
constexpr size_t M_GT = M_OPRE + AL((size_t)MA * 1024 * 2);
constexpr int NTOK_S = 16 * 4096 + 64 * 32;
constexpr size_t M_U = M_GT + AL((size_t)MA * 8 * 4);
constexpr size_t M_MT = M_U + AL((size_t)(NTOK_S + 64) * 4);
constexpr size_t M_BT = M_MT + AL((size_t)(NTOK_S + 64) * 4);
constexpr size_t M_WR = M_BT + AL((size_t)(NTOK_S + 64) * 4);
constexpr size_t M_MC = M_WR + AL((size_t)(NTOK_S + 64) * 4);
constexpr size_t M_DEC = M_MC + AL((size_t)1088 * 4);
static_assert(M_DEC + 1088 * 4 <= B_VT, "mlstm alias");
constexpr size_t M_VXP = B_VT;
constexpr size_t M_VXS = B_VT + AL((size_t)16 * 272 * 4096 * 2);
static_assert(M_VXS + (size_t)64 * 272 * 32 * 2 <= B_ATT, "vx alias");

constexpr int SMEM_BYTES = 65536;

struct Params {
  const float *x_prompt, *x_sample, *c_prompt, *c_sample, *cache_a_k, *cache_a_v, *state_b_c, *state_b_n,
      *state_b_m, *cache_c_kv, *cache_c_kr;
  const float *w_ada, *b_ada, *g_norm1, *g_norm2, *w_a_qkv, *a_lambda, *g_a_sub, *w_a_o, *w_b_in, *b_b_gates,
      *g_b_out, *w_b_out, *w_c_dq, *g_c_q, *w_c_uq, *w_c_dkv, *g_c_kv, *w_c_ukv, *w_c_o, *w_ffn_in, *w_ffn_out,
      *g_final;
  float* out;
  char* ws;
  float lam_init0, lam_init3;
};

DEV char* wsp(const Params& p) {
  const uint64_t w = (uint64_t)p.ws;
  uint32_t lo = __builtin_amdgcn_readfirstlane((uint32_t)w), hi = __builtin_amdgcn_readfirstlane((uint32_t)(w >> 32));
  asm volatile("" : "+s"(lo), "+s"(hi));
  return (char*)(((uint64_t)hi << 32) | lo);
}
typedef __bf16 bf16v2 __attribute__((ext_vector_type(2)));
typedef float f32v2 __attribute__((ext_vector_type(2)));
DEV uint32_t pack2(float a, float b) {
  f32v2 v = {a, b};
  bf16v2 r = __builtin_convertvector(v, bf16v2);
  return __builtin_bit_cast(uint32_t, r);
}
DEV bf16_t f2bf(float f) { return (bf16_t)(pack2(f, 0.f) & 0xffffu); }
DEV float bf2f(bf16_t h) { return __uint_as_float(((uint32_t)h) << 16); }
DEV uint2 pack4(float a, float b, float c, float d) { return make_uint2(pack2(a, b), pack2(c, d)); }
template <int M>
DEV float shx(float v) {
  return __int_as_float(__builtin_amdgcn_ds_swizzle(__float_as_int(v), (M << 10) | 0x1f));
}
DEV float shx32(float v, int lane) {
  return __int_as_float(__builtin_amdgcn_ds_bpermute((lane ^ 32) << 2, __float_as_int(v)));
}
DEV float shfl_lane(float v, int src) {
  return __int_as_float(__builtin_amdgcn_ds_bpermute(src << 2, __float_as_int(v)));
}
DEV float xrow16_max(float x) {
  auto s = __builtin_amdgcn_permlane16_swap(__float_as_uint(x), __float_as_uint(x), false, false);
  x = fmaxf(__uint_as_float(s[0]), __uint_as_float(s[1]));
  auto t = __builtin_amdgcn_permlane32_swap(__float_as_uint(x), __float_as_uint(x), false, false);
  return fmaxf(__uint_as_float(t[0]), __uint_as_float(t[1]));
}
DEV float xrow16_sum(float x) {
  auto s = __builtin_amdgcn_permlane16_swap(__float_as_uint(x), __float_as_uint(x), false, false);
  x = __uint_as_float(s[0]) + __uint_as_float(s[1]);
  auto t = __builtin_amdgcn_permlane32_swap(__float_as_uint(x), __float_as_uint(x), false, false);
  return __uint_as_float(t[0]) + __uint_as_float(t[1]);
}
DEV float wave_sum(float v, int lane) {
  v += shx32(v, lane);
  v += shx<16>(v); v += shx<8>(v); v += shx<4>(v); v += shx<2>(v); v += shx<1>(v);
  return v;
}
DEV float siluf(float a) { return a * __builtin_amdgcn_rcpf(1.f + __expf(-a)); }
DEV float sigmoidf(float a) { return __builtin_amdgcn_rcpf(1.f + __expf(-a)); }
DEV f32x4 mfma16(bf16x8 a, bf16x8 b, f32x4 c) { return __builtin_amdgcn_mfma_f32_16x16x32_bf16(a, b, c, 0, 0, 0); }
DEV bf16x8 ld8(const bf16_t* p) { return *reinterpret_cast<const bf16x8*>(p); }
DEV bf16x8 ld2x4(const bf16_t* p0, const bf16_t* p1) {
  bf16x4 a = *reinterpret_cast<const bf16x4*>(p0);
  bf16x4 b = *reinterpret_cast<const bf16x4*>(p1);
  return __builtin_shufflevector(a, b, 0, 1, 2, 3, 4, 5, 6, 7);
}
DEV bf16x8 packP(f32x4 a, f32x4 b) {
  u32x4 r = {pack2(a[0], a[1]), pack2(a[2], a[3]), pack2(b[0], b[1]), pack2(b[2], b[3])};
  return __builtin_bit_cast(bf16x8, r);
}
DEV int otid() { int t = threadIdx.x; asm volatile("" : "+v"(t)); return t; }
DEV int row_slot(int row) { return row < MP ? (row >> 12) : 4 + ((row - MP) >> 5); }
DEV int row_pos(int row) { return row < MP ? (row & 4095) : 2048 + ((row - MP) & 31); }
DEV int row_kv(int row) { return row < MP ? row : MP + ((row - MP) >> 5) * SKV + 2048 + ((row - MP) & 31); }

DEV int lds_byte(int r, int c) {
  const int st = (r >> 4) * 2 + (c >> 5), rr = r & 15, cc = c & 31, ob = rr * 64 + cc * 2;
  return st * 1024 + (ob ^ (((ob >> 9) & 1) << 5));
}
DEV void stage_rc(int b, int& R, int& C) {
  const int st = b >> 10, sb = b & 1023, swz = sb ^ (((sb >> 9) & 1) << 5);
  R = (st >> 1) * 16 + (swz >> 6);
  C = (st & 1) * 32 + ((swz & 63) >> 1);
}
DEV int gt_off(int r, int c16) { return (r >> 3) * 1024 + (r & 7) * 128 + ((c16 ^ ((r >> 1) & 7)) << 4); }
DEV void stage_tile128(const bf16_t* __restrict__ G, int ld, int k0, char* lds, int tid) {
#pragma unroll
  for (int i = 0; i < 4; ++i) {
    const int b = tid * 16 + i * 4096;
    const int R = (b >> 10) * 8 + ((b >> 7) & 7);
    const int C = ((((b >> 4) & 7) ^ ((R >> 1) & 7))) * 8;
    __builtin_amdgcn_global_load_lds((const __attribute__((address_space(1))) void*)(G + (size_t)R * ld + k0 + C),
                                     (__attribute__((address_space(3))) void*)(lds + b), 16, 0, 0);
  }
}
#define WAIT_VM(n) asm volatile("s_waitcnt vmcnt(" #n ")" ::: "memory")
#define WAIT_LGKM0() asm volatile("s_waitcnt lgkmcnt(0)" ::: "memory")

DEV void gemm_tile(const bf16_t* __restrict__ Ab, int lda, const bf16_t* __restrict__ Bb, int ldb, int kt0, int kt1,
                   f32x4 (&acc)[4][4], char* smem, const int (&aoff)[4][2], const int (&boff)[4][2], int tid) {
#pragma unroll
  for (int i = 0; i < 4; ++i)
#pragma unroll
    for (int j = 0; j < 4; ++j) acc[i][j] = (f32x4){0.f, 0.f, 0.f, 0.f};
  __syncthreads();
  stage_tile128(Ab, lda, kt0 * 64, smem, tid);
  stage_tile128(Bb, ldb, kt0 * 64, smem + 16384, tid);
  for (int kt = kt0; kt < kt1; ++kt) {
    char* cur = smem + ((kt - kt0) & 1) * 32768;
    if (kt + 1 < kt1) {
      char* nxt = smem + ((kt + 1 - kt0) & 1) * 32768;
      stage_tile128(Ab, lda, (kt + 1) * 64, nxt, tid);
      stage_tile128(Bb, ldb, (kt + 1) * 64, nxt + 16384, tid);
      WAIT_VM(8);
    } else {
      WAIT_VM(0);
    }
    __builtin_amdgcn_s_barrier();
#pragma unroll
    for (int ks = 0; ks < 2; ++ks) {
      bf16x8 af[4], bfr[4];
#pragma unroll
      for (int mi = 0; mi < 4; ++mi) af[mi] = *reinterpret_cast<const bf16x8*>(cur + aoff[mi][ks]);
#pragma unroll
      for (int ni = 0; ni < 4; ++ni) bfr[ni] = *reinterpret_cast<const bf16x8*>(cur + boff[ni][ks]);
#pragma unroll
      for (int mi = 0; mi < 4; ++mi)
#pragma unroll
        for (int ni = 0; ni < 4; ++ni) acc[mi][ni] = mfma16(af[mi], bfr[ni], acc[mi][ni]);
    }
    WAIT_LGKM0();
    __builtin_amdgcn_s_barrier();
  }
}

#define GEMM_SETUP()                                                                  \
  const int tid = otid(), lane = tid & 63, wave = tid >> 6;                           \
  const int wm = wave >> 1, wn = wave & 1;                                            \
  const int l15 = lane & 15, q4 = lane >> 4;                                          \
  int aoff[4][2], boff[4][2];                                                         \
  _Pragma("unroll") for (int i = 0; i < 4; ++i)                                       \
  _Pragma("unroll") for (int ks = 0; ks < 2; ++ks) {                                  \
    aoff[i][ks] = gt_off(wm * 64 + i * 16 + l15, ks * 4 + q4);                        \
    boff[i][ks] = 16384 + gt_off(wn * 64 + i * 16 + l15, ks * 4 + q4);                \
  }

template <class Epi>
DEV void gemm_phase(const bf16_t* __restrict__ A, int lda, const bf16_t* __restrict__ B, int ldb, int MT, int NT,
                    int K, const Epi& epi, char* smem) {
  GEMM_SETUP();
  const int KT = K >> 6;
  const int xcd = blockIdx.x & 7, xl = blockIdx.x >> 3, xstride = gridDim.x >> 3;
  const int m0 = (MT * xcd) >> 3, msz = ((MT * (xcd + 1)) >> 3) - m0;
  const int xcnt = msz * NT;
  for (int q = xl; q < xcnt; q += xstride) {
    const int tm = m0 + q % msz, tn = q / msz;
    f32x4 acc[4][4];
    gemm_tile(A + (size_t)tm * 128 * lda, lda, B + (size_t)tn * 128 * ldb, ldb, 0, KT, acc, smem, aoff, boff, tid);
    epi(tm * 128 + wm * 64, tn * 128 + wn * 64, acc, lane);
  }
  __syncthreads();
}

DEV void gemm_wide_tile(const bf16_t* __restrict__ Ab, int lda, const bf16_t* __restrict__ Bb, int ldb, int KT,
                        f32x4 (&accL)[4][4], f32x4 (&accR)[4][4], char* smem, const int (&aoff)[4][2],
                        const int (&boff)[8][2], int tid) {
#pragma unroll
  for (int i = 0; i < 4; ++i)
#pragma unroll
    for (int j = 0; j < 4; ++j) { accL[i][j] = (f32x4){0.f, 0.f, 0.f, 0.f}; accR[i][j] = (f32x4){0.f, 0.f, 0.f, 0.f}; }
  for (int kt = 0; kt < KT; ++kt) {
    __syncthreads();
    stage_tile128(Ab, lda, kt * 64, smem, tid);
    stage_tile128(Bb, ldb, kt * 64, smem + 16384, tid);
    stage_tile128(Bb + (size_t)128 * ldb, ldb, kt * 64, smem + 32768, tid);
    WAIT_VM(0);
    __builtin_amdgcn_s_barrier();
#pragma unroll
    for (int ks = 0; ks < 2; ++ks) {
      bf16x8 af[4], bfr[4];
#pragma unroll
      for (int mi = 0; mi < 4; ++mi) af[mi] = *reinterpret_cast<const bf16x8*>(smem + aoff[mi][ks]);
#pragma unroll
      for (int ni = 0; ni < 4; ++ni) bfr[ni] = *reinterpret_cast<const bf16x8*>(smem + boff[ni][ks]);
#pragma unroll
      for (int mi = 0; mi < 4; ++mi)
#pragma unroll
        for (int ni = 0; ni < 4; ++ni) accL[mi][ni] = mfma16(af[mi], bfr[ni], accL[mi][ni]);
#pragma unroll
      for (int ni = 0; ni < 4; ++ni) bfr[ni] = *reinterpret_cast<const bf16x8*>(smem + boff[4 + ni][ks]);
#pragma unroll
      for (int mi = 0; mi < 4; ++mi)
#pragma unroll
        for (int ni = 0; ni < 4; ++ni) accR[mi][ni] = mfma16(af[mi], bfr[ni], accR[mi][ni]);
    }
    WAIT_LGKM0();
  }
}

#define GEMM_WIDE_SETUP()                                                             \
  const int tid = otid(), lane = tid & 63, wave = tid >> 6;                           \
  const int wm = wave >> 1, wn = wave & 1;                                            \
  const int l15 = lane & 15, q4 = lane >> 4;                                          \
  int aoff[4][2], boff[8][2];                                                         \
  _Pragma("unroll") for (int ks = 0; ks < 2; ++ks) {                                  \
    _Pragma("unroll") for (int i = 0; i < 4; ++i) aoff[i][ks] = gt_off(wm * 64 + i * 16 + l15, ks * 4 + q4); \
    _Pragma("unroll") for (int i = 0; i < 8; ++i) boff[i][ks] = 16384 + wn * 16384 + gt_off(i * 16 + l15, ks * 4 + q4); \
  }

template <bool STASH, class Epi>
DEV void gemm_wide_phase(const bf16_t* __restrict__ A, int lda, const bf16_t* __restrict__ B, int ldb, int MT, int NT2,
                         int K, const Epi& epi, char* smem) {
  GEMM_WIDE_SETUP();
  const int KT = K >> 6;
  const int xcd = blockIdx.x & 7, xl = blockIdx.x >> 3, xstride = gridDim.x >> 3;
  const int m0 = (MT * xcd) >> 3, msz = ((MT * (xcd + 1)) >> 3) - m0;
  const int xcnt = msz * NT2;
  for (int q = xl; q < xcnt; q += xstride) {
    const int tm = m0 + q % msz, tn = q / msz;
    f32x4 accL[4][4], accR[4][4];
    gemm_wide_tile(A + (size_t)tm * 128 * lda, lda, B + (size_t)tn * 256 * ldb, ldb, KT, accL, accR, smem, aoff, boff, tid);
    if (STASH) {
      __syncthreads();
      f32x4* stp = (f32x4*)(smem + wave * 16384);
#pragma unroll
      for (int mi = 0; mi < 4; ++mi)
#pragma unroll
        for (int ni = 0; ni < 4; ++ni) stp[(mi * 4 + ni) * 64 + lane] = accR[mi][ni];
    }
    epi(tm * 128 + wm * 64, tn * 256 + wn * 128, accL, lane);
    if (STASH) {
      const f32x4* stp = (const f32x4*)(smem + wave * 16384);
#pragma unroll
      for (int mi = 0; mi < 4; ++mi)
#pragma unroll
        for (int ni = 0; ni < 4; ++ni) accR[mi][ni] = stp[(mi * 4 + ni) * 64 + lane];
    }
    epi(tm * 128 + wm * 64, tn * 256 + wn * 128 + 64, accR, lane);
  }
  __syncthreads();
}

template <class Epi>
DEV void gemm_res_phase(const bf16_t* __restrict__ A, int lda, const bf16_t* __restrict__ B, int ldb, int K, int KSPL,
                        const Epi& epi, float* part, char* smem) {
  constexpr int MTP = MP / 128;
  const int KT = K >> 6, KPER = KT / KSPL;
  {
    GEMM_WIDE_SETUP();
    const int xcd = blockIdx.x & 7, xl = blockIdx.x >> 3, xstride = gridDim.x >> 3;
    const int m0 = (MTP * xcd) >> 3, msz = ((MTP * (xcd + 1)) >> 3) - m0;
    const int xcnt = msz * 4;
    for (int q = xl; q < xcnt; q += xstride) {
      const int tm = m0 + q % msz, tn = q / msz;
      f32x4 accL[4][4], accR[4][4];
      gemm_wide_tile(A + (size_t)tm * 128 * lda, lda, B + (size_t)tn * 256 * ldb, ldb, KT, accL, accR, smem, aoff, boff, tid);
      epi(tm * 128 + wm * 64, tn * 256 + wn * 128, accL, lane);
      epi(tm * 128 + wm * 64, tn * 256 + wn * 128 + 64, accR, lane);
    }
  }
  {
    GEMM_SETUP();
    const int nsub = (MA / 128 - MTP) * 8 * KSPL;
    for (int sidx = blockIdx.x; sidx < nsub; sidx += gridDim.x) {
      const int kp = sidx % KSPL, st = sidx / KSPL;
      const int tm = MTP + (st & 3), tn = st >> 2;
      f32x4 acc[4][4];
      gemm_tile(A + (size_t)tm * 128 * lda, lda, B + (size_t)tn * 128 * ldb, ldb, kp * KPER, kp * KPER + KPER, acc, smem, aoff,
                boff, tid);
      epi.partial(tm * 128 + wm * 64, tn * 128 + wn * 64, acc, lane, part + (size_t)kp * MS * 1024);
    }
  }
  __syncthreads();
}

struct EpiRes {
  float* x;
  const float* gate;
  DEV void operator()(int rb, int cb, f32x4 (&acc)[4][4], int lane) const {
    const int l15 = lane & 15, q4 = lane >> 4;
#pragma unroll
    for (int mi = 0; mi < 4; ++mi)
#pragma unroll
      for (int jh = 0; jh < 4; jh += 2) {
        float xv[2][4], gv[2][4];
#pragma unroll
        for (int j = 0; j < 2; ++j) {
          const int row = rb + mi * 16 + q4 * 4 + jh + j;
          const int slot = row_slot(row);
#pragma unroll
          for (int ni = 0; ni < 4; ++ni) {
            const int col = cb + ni * 16 + l15;
            xv[j][ni] = x[(size_t)row * 1024 + col];
            gv[j][ni] = gate[slot * 6144 + col];
          }
        }
#pragma unroll
        for (int j = 0; j < 2; ++j) {
          const int row = rb + mi * 16 + q4 * 4 + jh + j;
#pragma unroll
          for (int ni = 0; ni < 4; ++ni) x[(size_t)row * 1024 + cb + ni * 16 + l15] = xv[j][ni] + gv[j][ni] * acc[mi][ni][jh + j];
        }
      }
  }
  DEV void partial(int rb, int cb, f32x4 (&acc)[4][4], int lane, float* part) const {
    const int l15 = lane & 15, q4 = lane >> 4;
#pragma unroll
    for (int mi = 0; mi < 4; ++mi)
#pragma unroll
      for (int j = 0; j < 4; ++j) {
        const int row = rb + mi * 16 + q4 * 4 + j;
        const int slot = row_slot(row);
#pragma unroll
        for (int ni = 0; ni < 4; ++ni) {
          const int col = cb + ni * 16 + l15;
          part[(size_t)(row - MP) * 1024 + col] = gate[slot * 6144 + col] * acc[mi][ni][j];
        }
      }
  }
};

struct EpiSwiglu {
  bf16_t* act;
  DEV void operator()(int rb, int cb, f32x4 (&acc)[4][4], int lane) const {
    const int l15 = lane & 15, q4 = lane >> 4;
#pragma unroll
    for (int mi = 0; mi < 4; ++mi)
#pragma unroll
      for (int j = 0; j < 4; ++j) {
        const int row = rb + mi * 16 + q4 * 4 + j;
#pragma unroll
        for (int ni = 0; ni < 4; ni += 2) {
          const float a = acc[mi][ni][j], b = acc[mi][ni + 1][j];
          const int oc = ((cb + ni * 16) >> 1) + l15;
          act[(size_t)row * 2816 + oc] = f2bf(siluf(a) * b);
        }
      }
  }
};

struct EpiF32 {
  float* raw;
  DEV void operator()(int rb, int cb, f32x4 (&acc)[4][4], int lane) const {
    const int l15 = lane & 15, q4 = lane >> 4;
#pragma unroll
    for (int mi = 0; mi < 4; ++mi)
#pragma unroll
      for (int j = 0; j < 4; ++j) {
        const int row = rb + mi * 16 + q4 * 4 + j;
#pragma unroll
        for (int ni = 0; ni < 4; ++ni) raw[(size_t)row * 768 + cb + ni * 16 + l15] = acc[mi][ni][j];
      }
  }
};

struct EpiQKV {
  bf16_t *Q, *Kall, *Vtp, *Vts;
  float *akp, *aks, *avp, *avs;
  const float2* ropa;
  DEV void operator()(int rb, int cb, f32x4 (&acc)[4][4], int lane) const {
    const int l15 = lane & 15, q4 = lane >> 4;
    const int part = cb >> 10, c0 = cb & 1023;
    if (part < 2) {
      f32v2 rt[4][4];
#pragma unroll
      for (int mi = 0; mi < 4; ++mi)
#pragma unroll
        for (int j = 0; j < 4; ++j) rt[mi][j] = ((const f32v2*)ropa)[row_pos(rb + mi * 16 + q4 * 4 + j) * 8 + (l15 & 7)];
#pragma unroll
      for (int mi = 0; mi < 4; ++mi)
#pragma unroll
        for (int j = 0; j < 4; ++j) {
          const float cs = rt[mi][j][0], sn = rt[mi][j][1];
          const float own = acc[mi][0][j];
          const float oth = shx<8>(own);
          acc[mi][0][j] = (l15 < 8) ? (own * cs - oth * sn) : (own * cs + oth * sn);
        }
      if (part == 0) {
        const float qs = 0.125f * LOG2E;
#pragma unroll
        for (int mi = 0; mi < 4; ++mi)
#pragma unroll
          for (int j = 0; j < 4; ++j) {
            const int row = rb + mi * 16 + q4 * 4 + j;
#pragma unroll
            for (int ni = 0; ni < 4; ++ni) Q[(size_t)row * 1024 + c0 + ni * 16 + l15] = f2bf(acc[mi][ni][j] * qs);
          }
      } else {
#pragma unroll
        for (int mi = 0; mi < 4; ++mi)
#pragma unroll
          for (int j = 0; j < 4; ++j) {
            const int row = rb + mi * 16 + q4 * 4 + j;
            const int kvr = row_kv(row);
            float* o = (row < MP) ? (akp + (size_t)row * 1024) : (aks + (size_t)(row - MP) * 1024);
#pragma unroll
            for (int ni = 0; ni < 4; ++ni) {
              const int c = c0 + ni * 16 + l15;
              __builtin_nontemporal_store(acc[mi][ni][j], o + c);
              Kall[(size_t)kvr * 1024 + c] = f2bf(acc[mi][ni][j]);
            }
          }
      }
    } else {
#pragma unroll
      for (int mi = 0; mi < 4; ++mi) {
        const int row0 = rb + mi * 16 + q4 * 4;
#pragma unroll
        for (int j = 0; j < 4; ++j) {
          const int row = row0 + j;
          float* o = (row < MP) ? (avp + (size_t)row * 1024) : (avs + (size_t)(row - MP) * 1024);
#pragma unroll
          for (int ni = 0; ni < 4; ++ni) __builtin_nontemporal_store(acc[mi][ni][j], o + c0 + ni * 16 + l15);
        }
#pragma unroll
        for (int ni = 0; ni < 4; ++ni) {
          const int c = c0 + ni * 16 + l15;
          bf16_t* d;
          if (row0 < MP) d = Vtp + ((size_t)((row0 >> 12) * 1024 + c)) * 4096 + (row0 & 4095);
          else { const int r = row0 - MP; d = Vts + ((size_t)((r >> 5) * 1024 + c)) * VTS_LD + 2048 + (r & 31); }
          *reinterpret_cast<uint2*>(d) = pack4(acc[mi][ni][0], acc[mi][ni][1], acc[mi][ni][2], acc[mi][ni][3]);
        }
      }
    }
  }
};

struct EpiBin {
  bf16_t *Qb, *Kb, *Ktp, *Kts, *Vxp, *Vxs, *Opre;
  float* Gt;
  DEV void operator()(int rb, int cb, f32x4 (&acc)[4][4], int lane) const {
    const int l15 = lane & 15, q4 = lane >> 4;
    if (cb < 512) {
#pragma unroll
      for (int mi = 0; mi < 4; ++mi)
#pragma unroll
        for (int j = 0; j < 4; ++j) {
          const int row = rb + mi * 16 + q4 * 4 + j;
#pragma unroll
          for (int ni = 0; ni < 4; ++ni) Qb[(size_t)row * 512 + cb + ni * 16 + l15] = f2bf(acc[mi][ni][j]);
        }
    } else if (cb < 1024) {
      const float ksc = 0.08838834764831845f;
#pragma unroll
      for (int mi = 0; mi < 4; ++mi) {
        const int row0 = rb + mi * 16 + q4 * 4;
#pragma unroll
        for (int ni = 0; ni < 4; ++ni) {
          const int c = cb - 512 + ni * 16 + l15;
          const float k0 = acc[mi][ni][0] * ksc, k1 = acc[mi][ni][1] * ksc, k2 = acc[mi][ni][2] * ksc,
                      k3 = acc[mi][ni][3] * ksc;
          Kb[(size_t)(row0 + 0) * 512 + c] = f2bf(k0);
          Kb[(size_t)(row0 + 1) * 512 + c] = f2bf(k1);
          Kb[(size_t)(row0 + 2) * 512 + c] = f2bf(k2);
          Kb[(size_t)(row0 + 3) * 512 + c] = f2bf(k3);
          bf16_t* d;
          if (row0 < MP) d = Ktp + ((size_t)((row0 >> 12) * 512 + c)) * 4096 + (row0 & 4095);
          else { const int r = row0 - MP; d = Kts + ((size_t)((r >> 5) * 512 + c)) * 32 + (r & 31); }
          *reinterpret_cast<uint2*>(d) = pack4(k0, k1, k2, k3);
        }
      }
    } else if (cb < 2048) {
#pragma unroll
      for (int mi = 0; mi < 4; ++mi) {
        const int row0 = rb + mi * 16 + q4 * 4;
#pragma unroll
        for (int ni = 0; ni < 4; ++ni) {
          const int c = cb - 1024 + ni * 16 + l15;
          const int hh = c >> 8, dv = c & 255;
          bf16_t* d;
          if (row0 < MP) d = Vxp + ((size_t)(((row0 >> 12) * 4 + hh) * 272 + dv)) * 4096 + (row0 & 4095);
          else { const int r = row0 - MP; d = Vxs + ((size_t)(((r >> 5) * 4 + hh) * 272 + dv)) * 32 + (r & 31); }
          *reinterpret_cast<uint2*>(d) = pack4(acc[mi][ni][0], acc[mi][ni][1], acc[mi][ni][2], acc[mi][ni][3]);
        }
      }
    } else if (cb < 3072) {
#pragma unroll
      for (int mi = 0; mi < 4; ++mi)
#pragma unroll
        for (int j = 0; j < 4; ++j) {
          const int row = rb + mi * 16 + q4 * 4 + j;
#pragma unroll
          for (int ni = 0; ni < 4; ++ni)
            Opre[(size_t)row * 1024 + cb - 2048 + ni * 16 + l15] = f2bf(sigmoidf(acc[mi][ni][j]));
        }
    } else if (cb == 3072) {
      if (l15 < 8) {
#pragma unroll
        for (int mi = 0; mi < 4; ++mi)
#pragma unroll
          for (int j = 0; j < 4; ++j) {
            const int row = rb + mi * 16 + q4 * 4 + j;
            Gt[(size_t)row * 8 + l15] = acc[mi][0][j];
          }
      }
    }
  }
};

struct EpiUQ {
  bf16_t* Qc;
  const float2* ropc;
  DEV void operator()(int rb, int cb, f32x4 (&acc)[4][4], int lane) const {
    const int l15 = lane & 15, q4 = lane >> 4;
    const int g = cb >> 6;
    if ((g % 3) == 2) {
      f32v2 r0t[4][4], r1t[4][4];
#pragma unroll
      for (int mi = 0; mi < 4; ++mi)
#pragma unroll
        for (int j = 0; j < 4; ++j) {
          const f32v2* rp = (const f32v2*)ropc + row_pos(rb + mi * 16 + q4 * 4 + j) * 32;
          r0t[mi][j] = rp[l15];
          r1t[mi][j] = rp[16 + l15];
        }
#pragma unroll
      for (int mi = 0; mi < 4; ++mi)
#pragma unroll
        for (int j = 0; j < 4; ++j) {
          {
            const f32v2 cssn = r0t[mi][j];
            const float x1 = acc[mi][0][j], x2 = acc[mi][2][j];
            acc[mi][0][j] = x1 * cssn[0] - x2 * cssn[1];
            acc[mi][2][j] = x2 * cssn[0] + x1 * cssn[1];
          }
          {
            const f32v2 cssn = r1t[mi][j];
            const float x1 = acc[mi][1][j], x2 = acc[mi][3][j];
            acc[mi][1][j] = x1 * cssn[0] - x2 * cssn[1];
            acc[mi][3][j] = x2 * cssn[0] + x1 * cssn[1];
          }
        }
    }
    const float qs = 0.07216878364870323f * LOG2E;
#pragma unroll
    for (int mi = 0; mi < 4; ++mi)
#pragma unroll
      for (int j = 0; j < 4; ++j) {
        const int row = rb + mi * 16 + q4 * 4 + j;
#pragma unroll
        for (int ni = 0; ni < 4; ++ni) Qc[(size_t)row * 1536 + cb + ni * 16 + l15] = f2bf(acc[mi][ni][j] * qs);
      }
  }
};

struct EpiUKV {
  bf16_t *Kf, *Vtp, *Vts;
  DEV void operator()(int rb, int cb, f32x4 (&acc)[4][4], int lane) const {
    const int l15 = lane & 15, q4 = lane >> 4;
    const int g = cb >> 6, head = g >> 2, part = g & 3;
    if (part < 2) {
#pragma unroll
      for (int mi = 0; mi < 4; ++mi)
#pragma unroll
        for (int j = 0; j < 4; ++j) {
          const int row = rb + mi * 16 + q4 * 4 + j;
#pragma unroll
          for (int ni = 0; ni < 4; ++ni)
            Kf[(size_t)row * 1536 + head * 192 + part * 64 + ni * 16 + l15] = f2bf(acc[mi][ni][j]);
        }
    } else {
#pragma unroll
      for (int mi = 0; mi < 4; ++mi) {
        const int row0 = rb + mi * 16 + q4 * 4;
#pragma unroll
        for (int ni = 0; ni < 4; ++ni) {
          const int c = head * 128 + (part - 2) * 64 + ni * 16 + l15;
          bf16_t* d;
          if (row0 < MP) d = Vtp + ((size_t)((row0 >> 12) * 1024 + c)) * 4096 + (row0 & 4095);
          else { const int r = row0 - MP; const int b = r / SKV; d = Vts + ((size_t)(b * 1024 + c)) * VTS_LD + (r - b * SKV); }
          *reinterpret_cast<uint2*>(d) = pack4(acc[mi][ni][0], acc[mi][ni][1], acc[mi][ni][2], acc[mi][ni][3]);
        }
      }
    }
  }
};

DEV void tconv_tile(const float* __restrict__ src, int R, int C, int lds_, bf16_t* __restrict__ dst, int ldd, int r0,
                    int c0, int mode, float* tile) {
  const int tx = otid() & 63, ty = otid() >> 6;
  float v[16];
#pragma unroll
  for (int i = 0; i < 16; ++i) {
    const int r = r0 + ty + 4 * i, c = c0 + tx;
    v[i] = (r < R && c < C) ? src[(size_t)r * lds_ + c] : 0.f;
  }
  __syncthreads();
#pragma unroll
  for (int i = 0; i < 16; ++i) tile[(ty + 4 * i) * 65 + tx] = v[i];
  __syncthreads();
#pragma unroll
  for (int jj = 0; jj < 16; ++jj) {
    const int j = ty + 4 * jj;
    const int c = c0 + j, r = r0 + tx;
    if (c < C && r < R) {
      int cm = c;
      if (mode == 1) {
        if (c < 2816) cm = (c >> 4) * 32 + (c & 15);
        else { const int c2 = c - 2816; cm = (c2 >> 4) * 32 + 16 + (c2 & 15); }
      }
      dst[(size_t)cm * ldd + r] = f2bf(tile[tx * 65 + j]);
    }
  }
}

DEV bool pick(int& w, int n) {
  if (w < n) return true;
  w -= n;
  return false;
}

constexpr int P0_TCONV = 768 * 2 + 256 * 2 + 784 + 256 + 96 + 80 + 144 + 128 + 256 + 1408 * 4 + 704 * 4;
constexpr int P0_MOD = 384;
constexpr int P0_XCOPY = MA * 256 / 2048;
constexpr int P0_ROPE = 640;
constexpr int P0_TOTAL = P0_TCONV + P0_MOD + P0_XCOPY + P0_ROPE;

DEV void phase0(const Params& p, char* smem) {
  char* ws = wsp(p);
  const int tid = otid(), lane = tid & 63, wave = tid >> 6;
  for (int item = blockIdx.x; item < P0_TOTAL; item += gridDim.x) {
    int w = item;
    if (w < P0_TCONV) {
      const float* src; bf16_t* dst; int R, C, ldd, mode = 0;
      if (pick(w, 768)) { src = p.w_a_qkv; dst = (bf16_t*)(ws + W_QKV); R = 1024; C = 3072; ldd = 1024; }
      else if (pick(w, 768)) { src = p.w_a_qkv + (size_t)1024 * 3072; dst = (bf16_t*)(ws + W_QKV) + (size_t)3072 * 1024; R = 1024; C = 3072; ldd = 1024; }
      else if (pick(w, 256)) { src = p.w_a_o; dst = (bf16_t*)(ws + W_AO); R = 1024; C = 1024; ldd = 1024; }
      else if (pick(w, 256)) { src = p.w_a_o + (size_t)1024 * 1024; dst = (bf16_t*)(ws + W_AO) + (size_t)1024 * 1024; R = 1024; C = 1024; ldd = 1024; }
      else if (pick(w, 784)) { src = p.w_b_in; dst = (bf16_t*)(ws + W_BIN); R = 1024; C = 3080; ldd = 1024; }
      else if (pick(w, 256)) { src = p.w_b_out; dst = (bf16_t*)(ws + W_BOUT); R = 1024; C = 1024; ldd = 1024; }
      else if (pick(w, 96)) { src = p.w_c_dq; dst = (bf16_t*)(ws + W_CD); R = 1024; C = 384; ldd = 1024; }
      else if (pick(w, 80)) { src = p.w_c_dkv; dst = (bf16_t*)(ws + W_CD) + (size_t)384 * 1024; R = 1024; C = 320; ldd = 1024; }
      else if (pick(w, 144)) { src = p.w_c_uq; dst = (bf16_t*)(ws + W_UQ); R = 384; C = 1536; ldd = 384; }
      else if (pick(w, 128)) { src = p.w_c_ukv; dst = (bf16_t*)(ws + W_UKV); R = 256; C = 2048; ldd = 256; }
      else if (pick(w, 256)) { src = p.w_c_o; dst = (bf16_t*)(ws + W_CO); R = 1024; C = 1024; ldd = 1024; }
      else if (w < 1408 * 4) { const int l = w / 1408; w -= l * 1408; src = p.w_ffn_in + (size_t)l * 1024 * 5632; dst = (bf16_t*)(ws + W_FIN) + (size_t)l * 5632 * 1024; R = 1024; C = 5632; ldd = 1024; mode = 1; }
      else { w -= 1408 * 4; const int l = w / 704; w -= l * 704; src = p.w_ffn_out + (size_t)l * 2816 * 1024; dst = (bf16_t*)(ws + W_FOUT) + (size_t)l * 1024 * 2816; R = 2816; C = 1024; ldd = 2816; }
      const int ct = (C + 63) >> 6;
      const int rt = w / ct, cc = w - rt * ct;
      tconv_tile(src, R, C, C, dst, ldd, rt * 64, cc * 64, mode, (float*)smem);
    } else if (w < P0_TCONV + P0_MOD) {
      w -= P0_TCONV;
      const int layer = w / 96, cgp = w % 96;
      const int n = cgp * 64 + lane;
      const float* wa = p.w_ada + (size_t)layer * 1024 * 6144;
      float acc[20];
#pragma unroll
      for (int s = 0; s < 20; ++s) acc[s] = 0.f;
      for (int kb = 0; kb < 4; ++kb) {
        const int k0 = wave * 256 + kb * 64;
        float sv[20];
#pragma unroll
        for (int s = 0; s < 20; ++s) {
          const float cv = (s < 4) ? p.c_prompt[s * 1024 + k0 + lane] : p.c_sample[(s - 4) * 1024 + k0 + lane];
          sv[s] = siluf(cv);
        }
#pragma unroll 8
        for (int kk = 0; kk < 64; ++kk) {
          const float wv = wa[(size_t)(k0 + kk) * 6144 + n];
#pragma unroll
          for (int s = 0; s < 20; ++s) acc[s] += __int_as_float(__builtin_amdgcn_readlane(__float_as_int(sv[s]), kk)) * wv;
        }
      }
      float* red = (float*)smem;
      __syncthreads();
#pragma unroll
      for (int s = 0; s < 20; ++s) red[(wave * 20 + s) * 64 + lane] = acc[s];
      __syncthreads();
      float* mod = (float*)(ws + B_MOD);
      for (int e = tid; e < 1280; e += 256) {
        const int s = e >> 6, c = e & 63;
        const float v = red[(0 * 20 + s) * 64 + c] + red[(1 * 20 + s) * 64 + c] + red[(2 * 20 + s) * 64 + c] +
                        red[(3 * 20 + s) * 64 + c] + p.b_ada[layer * 6144 + cgp * 64 + c];
        mod[(size_t)(layer * 20 + s) * 6144 + cgp * 64 + c] = v;
      }
    } else if (w >= P0_TCONV + P0_MOD + P0_XCOPY) {
      w -= P0_TCONV + P0_MOD + P0_XCOPY;
      const int e = w * 256 + tid;
      int pos, idx; float inv; float2* dstp;
      if (e < 32768) { pos = e >> 3; idx = e; inv = exp2f(-(float)(e & 7) * (LOG2_THETA / 8.f)); dstp = (float2*)(ws + B_ROPA); }
      else { const int e2 = e - 32768; pos = e2 >> 5; idx = e2; inv = exp2f(-(float)(e2 & 31) * (LOG2_THETA / 32.f)); dstp = (float2*)(ws + B_ROPC); }
      const float ang = (float)pos * inv;
      dstp[idx] = make_float2(cosf(ang), sinf(ang));
    } else {
      w -= P0_TCONV + P0_MOD;
      float4* xd = (float4*)(ws + B_X);
      f32x4 xv[8];
#pragma unroll
      for (int i = 0; i < 8; ++i) {
        const size_t idx = (size_t)w * 2048 + i * 256 + tid;
        const size_t row = idx >> 8;
        const f32x4* sp = (row < MP) ? ((const f32x4*)p.x_prompt + idx) : ((const f32x4*)p.x_sample + (idx - (size_t)MP * 256));
        xv[i] = *sp;
      }
#pragma unroll
      for (int i = 0; i < 8; ++i) ((f32x4*)xd)[(size_t)w * 2048 + i * 256 + tid] = xv[i];
    }
  }
}

DEV void norm_mod_phase(float* __restrict__ x, const float* __restrict__ g, const float* __restrict__ modl,
                        int shoff, int scoff, bf16_t* __restrict__ h, const float* __restrict__ part, int kspl) {
  const int lane = otid() & 63, wave = otid() >> 6;
  f32x4 gg[4];
#pragma unroll
  for (int i = 0; i < 4; ++i) gg[i] = ((const f32x4*)g)[lane + 64 * i];
  for (int row = blockIdx.x * 4 + wave; row < MA; row += gridDim.x * 4) {
    f32x4 v[4], sc[4], sh[4];
    const float* ms = modl + row_slot(row) * 6144;
#pragma unroll
    for (int i = 0; i < 4; ++i) {
      v[i] = ((const f32x4*)(x + (size_t)row * 1024))[lane + 64 * i];
      sc[i] = ((const f32x4*)(ms + scoff))[lane + 64 * i];
      sh[i] = ((const f32x4*)(ms + shoff))[lane + 64 * i];
    }
    if (row >= MP && kspl > 0) {
      for (int kp = 0; kp < kspl; ++kp) {
        const f32x4* pr = (const f32x4*)(part + ((size_t)kp * MS + (row - MP)) * 1024);
        f32x4 t[4];
#pragma unroll
        for (int i = 0; i < 4; ++i) t[i] = pr[lane + 64 * i];
#pragma unroll
        for (int i = 0; i < 4; ++i) v[i] += t[i];
      }
#pragma unroll
      for (int i = 0; i < 4; ++i) ((f32x4*)(x + (size_t)row * 1024))[lane + 64 * i] = v[i];
    }
    float ss = 0.f;
#pragma unroll
    for (int i = 0; i < 4; ++i) ss += v[i][0] * v[i][0] + v[i][1] * v[i][1] + v[i][2] * v[i][2] + v[i][3] * v[i][3];
    ss = wave_sum(ss, lane);
    const float r = rsqrtf(ss * (1.f / 1024.f) + EPSN);
#pragma unroll
    for (int i = 0; i < 4; ++i) {
      const int c4 = lane + 64 * i;
      const float y0 = v[i][0] * r * gg[i][0] * (1.f + sc[i][0]) + sh[i][0];
      const float y1 = v[i][1] * r * gg[i][1] * (1.f + sc[i][1]) + sh[i][1];
      const float y2 = v[i][2] * r * gg[i][2] * (1.f + sc[i][2]) + sh[i][2];
      const float y3 = v[i][3] * r * gg[i][3] * (1.f + sc[i][3]) + sh[i][3];
      *reinterpret_cast<uint2*>(h + (size_t)row * 1024 + c4 * 4) = pack4(y0, y1, y2, y3);
    }
  }
}

DEV void final_norm_phase(const float* __restrict__ x, const float* __restrict__ g, float* __restrict__ out,
                          const float* __restrict__ part, int kspl) {
  const int lane = otid() & 63, wave = otid() >> 6;
  f32x4 gg[4];
#pragma unroll
  for (int i = 0; i < 4; ++i) gg[i] = ((const f32x4*)g)[lane + 64 * i];
  for (int row = blockIdx.x * 4 + wave; row < MA; row += gridDim.x * 4) {
    f32x4 v[4];
    float ss = 0.f;
#pragma unroll
    for (int i = 0; i < 4; ++i) {
      v[i] = ((const f32x4*)(x + (size_t)row * 1024))[lane + 64 * i];
    }
    if (row >= MP && kspl > 0) {
      for (int kp = 0; kp < kspl; ++kp) {
        const f32x4* pr = (const f32x4*)(part + ((size_t)kp * MS + (row - MP)) * 1024);
        f32x4 t[4];
#pragma unroll
        for (int i = 0; i < 4; ++i) t[i] = pr[lane + 64 * i];
#pragma unroll
        for (int i = 0; i < 4; ++i) v[i] += t[i];
      }
    }
#pragma unroll
    for (int i = 0; i < 4; ++i) ss += v[i][0] * v[i][0] + v[i][1] * v[i][1] + v[i][2] * v[i][2] + v[i][3] * v[i][3];
    ss = wave_sum(ss, lane);
    const float r = rsqrtf(ss * (1.f / 1024.f) + EPSN);
    float* o = (row < MP) ? (out + O_YP + (size_t)row * 1024) : (out + O_YS + (size_t)(row - MP) * 1024);
#pragma unroll
    for (int i = 0; i < 4; ++i) {
      f32x4 y = v[i] * gg[i] * r;
      __builtin_nontemporal_store(y, (f32x4*)o + lane + 64 * i);
    }
  }
}

DEV void mla_norm_phase(const Params& p) {
  char* ws = wsp(p);
  const float* raw = (const float*)(ws + C_RAW);
  bf16_t* Qn = (bf16_t*)(ws + C_QN);
  bf16_t* KVB = (bf16_t*)(ws + C_KVB);
  bf16_t* Kf = (bf16_t*)(ws + B_K);
  const int lane = otid() & 63, wave = otid() >> 6;
  float gq[6], gkv[4];
#pragma unroll
  for (int i = 0; i < 6; ++i) gq[i] = p.g_c_q[lane + 64 * i];
#pragma unroll
  for (int i = 0; i < 4; ++i) gkv[i] = p.g_c_kv[lane + 64 * i];
  for (int row = blockIdx.x * 4 + wave; row < MA; row += gridDim.x * 4) {
    const float* rr = raw + (size_t)row * 768;
    const int kvr = row_kv(row);
    float v[6], u[4];
#pragma unroll
    for (int i = 0; i < 6; ++i) v[i] = rr[lane + 64 * i];
#pragma unroll
    for (int i = 0; i < 4; ++i) u[i] = rr[384 + lane + 64 * i];
    const float xr = rr[640 + lane];
    const f32v2 cssn = ((const f32v2*)(ws + B_ROPC))[row_pos(row) * 32 + (lane & 31)];
    float ss = 0.f;
#pragma unroll
    for (int i = 0; i < 6; ++i) ss += v[i] * v[i];
    ss = wave_sum(ss, lane);
    float r = rsqrtf(ss * (1.f / 384.f) + EPSN);
#pragma unroll
    for (int i = 0; i < 6; ++i) Qn[(size_t)row * 384 + lane + 64 * i] = f2bf(v[i] * r * gq[i]);
    ss = 0.f;
#pragma unroll
    for (int i = 0; i < 4; ++i) ss += u[i] * u[i];
    ss = wave_sum(ss, lane);
    r = rsqrtf(ss * (1.f / 256.f) + EPSN);
    float* okv = (row < MP) ? (p.out + O_CKVP + (size_t)row * 256) : (p.out + O_CKVS + (size_t)(row - MP) * 256);
#pragma unroll
    for (int i = 0; i < 4; ++i) {
      const float val = u[i] * r * gkv[i];
      okv[lane + 64 * i] = val;
      KVB[(size_t)kvr * 256 + lane + 64 * i] = f2bf(val);
    }
    const float oth = shx32(xr, lane);
    const float cs = cssn[0], sn = cssn[1];
    const float o = (lane < 32) ? (xr * cs - oth * sn) : (xr * cs + oth * sn);
    float* okr = (row < MP) ? (p.out + O_CKRP + (size_t)row * 64) : (p.out + O_CKRS + (size_t)(row - MP) * 64);
    okr[lane] = o;
    const bf16_t ob = f2bf(o);
#pragma unroll
    for (int hh = 0; hh < 8; ++hh) Kf[(size_t)kvr * 1536 + hh * 192 + 128 + lane] = ob;
  }
}

DEV void conv_cache_a(const Params& p, int j, char* smem) {
  char* ws = wsp(p);
  bf16_t* Kall = (bf16_t*)(ws + B_K);
  bf16_t* Vts = (bf16_t*)(ws + B_VT) + (size_t)4 * 1024 * 4096;
  const int tid = otid();
  for (int item = blockIdx.x; item < 4096 + 8192; item += gridDim.x) {
    if (item < 4096) {
      const int b = item >> 8, r0 = (item & 255) * 8;
      f32x4 kv[8];
#pragma unroll
      for (int i = 0; i < 8; ++i) {
        const int idx = tid + 256 * i, row = r0 + (idx >> 8), c4 = idx & 255;
        kv[i] = *(const f32x4*)(p.cache_a_k + ((size_t)((j * 16 + b) * 2048 + row)) * 1024 + c4 * 4);
      }
#pragma unroll
      for (int i = 0; i < 8; ++i) {
        const int idx = tid + 256 * i, row = r0 + (idx >> 8), c4 = idx & 255;
        *reinterpret_cast<uint2*>(Kall + ((size_t)(MP + b * SKV + row)) * 1024 + c4 * 4) = pack4(kv[i][0], kv[i][1], kv[i][2], kv[i][3]);
      }
    } else {
      const int w = item - 4096;
      const int b = w >> 9, t = w & 511, rt = t >> 4, ct = t & 15;
      tconv_tile(p.cache_a_v + ((size_t)(j * 16 + b) * 2048) * 1024, 2048, 1024, 1024, Vts + (size_t)b * 1024 * VTS_LD,
                 VTS_LD, rt * 64, ct * 64, 0, (float*)smem);
    }
  }
}

DEV void conv_cache_c(const Params& p) {
  char* ws = wsp(p);
  bf16_t* KVB = (bf16_t*)(ws + C_KVB);
  bf16_t* Kf = (bf16_t*)(ws + B_K);
  const int tid = otid();
  for (int item = blockIdx.x; item < 1024 + 256; item += gridDim.x) {
    if (item < 1024) {
      const int b = item >> 6, r0 = (item & 63) * 32;
      f32x4 kv[8];
#pragma unroll
      for (int i = 0; i < 8; ++i) {
        const int idx = tid + 256 * i, row = r0 + (idx >> 6), c4 = idx & 63;
        kv[i] = *(const f32x4*)(p.cache_c_kv + ((size_t)(b * 2048 + row)) * 256 + c4 * 4);
      }
#pragma unroll
      for (int i = 0; i < 8; ++i) {
        const int idx = tid + 256 * i, row = r0 + (idx >> 6), c4 = idx & 63;
        *reinterpret_cast<uint2*>(KVB + ((size_t)(MP + b * SKV + row)) * 256 + c4 * 4) = pack4(kv[i][0], kv[i][1], kv[i][2], kv[i][3]);
      }
    } else {
      const int w = item - 1024;
      const int b = w >> 4, r0 = (w & 15) * 128;
      f32x4 kv[8];
#pragma unroll
      for (int i = 0; i < 8; ++i) {
        const int idx = tid + 256 * i, row = r0 + (idx >> 4), c4 = idx & 15;
        kv[i] = *(const f32x4*)(p.cache_c_kr + ((size_t)(b * 2048 + row)) * 64 + c4 * 4);
      }
#pragma unroll
      for (int i = 0; i < 8; ++i) {
        const int idx = tid + 256 * i, row = r0 + (idx >> 4), c4 = idx & 15;
        const uint2 pk = pack4(kv[i][0], kv[i][1], kv[i][2], kv[i][3]);
#pragma unroll
        for (int hh = 0; hh < 8; ++hh)
          *reinterpret_cast<uint2*>(Kf + ((size_t)(MP + b * SKV + row)) * 1536 + hh * 192 + 128 + c4 * 4) = pk;
      }
    }
  }
}

DEV void init_vx_rows(const Params& p) {
  char* ws = wsp(p);
  bf16_t* Vxp = (bf16_t*)(ws + M_VXP);
  bf16_t* Vxs = (bf16_t*)(ws + M_VXS);
  const int gt = blockIdx.x * 256 + otid(), gs = gridDim.x * 256;
  for (int e = gt; e < 16 * 16 * 4096; e += gs) {
    const int s = e >> 16, r = (e >> 12) & 15, t = e & 4095;
    Vxp[((size_t)(s * 272 + 256 + r)) * 4096 + t] = (r == 0) ? (bf16_t)0x3F80 : (bf16_t)0;
  }
  for (int e = gt; e < 64 * 16 * 32; e += gs) {
    const int s = e >> 9, r = (e >> 5) & 15, t = e & 31;
    Vxs[((size_t)(s * 272 + 256 + r)) * 32 + t] = (r == 0) ? (bf16_t)0x3F80 : (bf16_t)0;
  }
}

template <int N>
DEV void wait_vm() { asm volatile("s_waitcnt vmcnt(%0)" ::"n"(N) : "memory"); }

template <int NSUB, int DQK, bool KDB>
DEV void attn_core(const bf16_t* __restrict__ Qp, int ldq, int qrow, const bf16_t* __restrict__ Kp, int ldk,
                   const bf16_t* __restrict__ Vtp, int ldv, int nkeys, f32x4 (&O)[NSUB][8], char* smem) {
  constexpr int KW = NSUB * DQK, KS = DQK / 32, CT = KW / 32;
  constexpr int KBYTES = 64 * KW * 2;
  constexpr int NKL = KBYTES / 4096;
  char* sKb = smem;
  char* sV0 = smem + (KDB ? 2 : 1) * KBYTES;
  const int tid = otid(), lane = tid & 63;
  const int l15 = lane & 15, q4 = lane >> 4;
  bf16x8 qf[NSUB][KS];
#pragma unroll
  for (int s = 0; s < NSUB; ++s)
#pragma unroll
    for (int ks = 0; ks < KS; ++ks) qf[s][ks] = ld8(Qp + (size_t)qrow * ldq + s * DQK + ks * 32 + q4 * 8);
  float m[NSUB], lsum[NSUB];
#pragma unroll
  for (int s = 0; s < NSUB; ++s) {
    m[s] = -INFINITY; lsum[s] = 0.f;
#pragma unroll
    for (int dt = 0; dt < 8; ++dt) O[s][dt] = (f32x4){0.f, 0.f, 0.f, 0.f};
  }
  const int ntiles = (nkeys + 63) >> 6;
  int krow[NKL], kcol[NKL];
#pragma unroll
  for (int i = 0; i < NKL; ++i) {
    const int bq = tid * 16 + i * 4096;
    const int cbk = bq >> 13, bb = bq & 8191;
    krow[i] = (bb >> 10) * 8 + ((bb >> 7) & 7);
    kcol[i] = cbk * 64 + ((((bb >> 4) & 7) ^ (((krow[i] >> 1) & 1) | (((krow[i] >> 3) & 3) << 1))) << 3);
  }
  auto stageK = [&](int kt) {
    char* kdst = sKb + (KDB ? (kt & 1) * KBYTES : 0);
#pragma unroll
    for (int i = 0; i < NKL; ++i) {
      const int key = min(kt * 64 + krow[i], nkeys - 1);
      __builtin_amdgcn_global_load_lds((const __attribute__((address_space(1))) void*)(Kp + (size_t)key * ldk + kcol[i]),
                                       (__attribute__((address_space(3))) void*)(kdst + tid * 16 + i * 4096), 16, 0, 0);
    }
  };
  auto stageV = [&](int kt) {
    char* dst = sV0 + (kt & 1) * 16384;
#pragma unroll
    for (int i = 0; i < 4; ++i) {
      const int bq = tid * 16 + i * 4096;
      const int R = (bq >> 10) * 8 + ((bq >> 7) & 7);
      const int C = ((((bq >> 4) & 7) ^ ((R >> 1) & 7))) << 3;
      __builtin_amdgcn_global_load_lds((const __attribute__((address_space(1))) void*)(Vtp + (size_t)R * ldv + kt * 64 + C),
                                       (__attribute__((address_space(3))) void*)(dst + bq), 16, 0, 0);
    }
  };
  __syncthreads();
  stageK(0);
  stageV(0);
  for (int kt = 0; kt < ntiles; ++kt) {
    const char* sV = sV0 + (kt & 1) * 16384;
    wait_vm<0>();
    __builtin_amdgcn_s_barrier();
    if (kt + 1 < ntiles) { stageV(kt + 1); if (KDB) stageK(kt + 1); }
    const char* sKc = sKb + (KDB ? (kt & 1) * KBYTES : 0);
    f32x4 st[NSUB][4];
#pragma unroll
    for (int s = 0; s < NSUB; ++s)
#pragma unroll
      for (int t4 = 0; t4 < 4; ++t4) {
        st[s][t4] = (f32x4){0.f, 0.f, 0.f, 0.f};
#pragma unroll
        for (int ks = 0; ks < KS; ++ks) {
          const int colk = s * DQK + ks * 32 + q4 * 8;
          const int rk = (t4 >> 1) * 32 + (l15 >> 2) * 8 + (t4 & 1) * 4 + (l15 & 3);
          const int off = (colk >> 6) * 8192 + (rk >> 3) * 1024 + (rk & 7) * 128 +
                          ((((colk & 63) >> 3) ^ (((rk >> 1) & 1) | (((rk >> 3) & 3) << 1))) << 4);
          st[s][t4] = mfma16(*reinterpret_cast<const bf16x8*>(sKc + off), qf[s][ks], st[s][t4]);
        }
      }
    if (!KDB) {
      WAIT_LGKM0();
      __builtin_amdgcn_s_barrier();
      if (kt + 1 < ntiles) stageK(kt + 1);
    }
    bf16x8 pf[NSUB][2];
    const bool tail = (kt == ntiles - 1) && ((nkeys & 63) != 0);
#pragma unroll
    for (int s = 0; s < NSUB; ++s) {
      if (tail) {
#pragma unroll
        for (int t4 = 0; t4 < 4; ++t4)
#pragma unroll
          for (int j = 0; j < 4; ++j)
            if (kt * 64 + (t4 >> 1) * 32 + q4 * 8 + (t4 & 1) * 4 + j >= nkeys) st[s][t4][j] = -INFINITY;
      }
      float mx = st[s][0][0];
#pragma unroll
      for (int t4 = 0; t4 < 4; ++t4)
#pragma unroll
        for (int j = 0; j < 4; ++j) mx = fmaxf(mx, st[s][t4][j]);
      mx = xrow16_max(mx);
      float alpha = 1.f;
      if (__builtin_amdgcn_ballot_w64(mx - m[s] > 8.f) != 0ull) {
        const float mnew = fmaxf(m[s], mx);
        alpha = __builtin_amdgcn_exp2f(m[s] - mnew);
        m[s] = mnew;
        if (__builtin_amdgcn_ballot_w64(alpha != 1.f) != 0ull) {
#pragma unroll
          for (int dt = 0; dt < 8; ++dt) {
            O[s][dt][0] *= alpha; O[s][dt][1] *= alpha; O[s][dt][2] *= alpha; O[s][dt][3] *= alpha;
          }
        }
      }
      const float mcur = m[s];
      float ps = 0.f;
#pragma unroll
      for (int t4 = 0; t4 < 4; ++t4)
#pragma unroll
        for (int j = 0; j < 4; ++j) {
          const float pv = __builtin_amdgcn_exp2f(st[s][t4][j] - mcur);
          st[s][t4][j] = pv;
          ps += pv;
        }
      lsum[s] = lsum[s] * alpha + ps;
      pf[s][0] = packP(st[s][0], st[s][1]);
      pf[s][1] = packP(st[s][2], st[s][3]);
    }
#pragma unroll
    for (int dt = 0; dt < 8; ++dt)
#pragma unroll
      for (int kk = 0; kk < 2; ++kk) {
        const bf16x8 vf = *reinterpret_cast<const bf16x8*>(sV + gt_off(dt * 16 + l15, kk * 4 + q4));
#pragma unroll
        for (int s = 0; s < NSUB; ++s) O[s][dt] = mfma16(vf, pf[s][kk], O[s][dt]);
      }
  }
#pragma unroll
  for (int s = 0; s < NSUB; ++s) {
    float l = lsum[s];
    l = xrow16_sum(l);
    const float il = 1.f / l;
#pragma unroll
    for (int dt = 0; dt < 8; ++dt) {
      O[s][dt][0] *= il; O[s][dt][1] *= il; O[s][dt][2] *= il; O[s][dt][3] *= il;
    }
  }
}

DEV void attn_item_decode(int item, int& b, int& h, int& qrow0, int& nq, int& kvrow0, int& nkeys, bool& samp) {
  if (item >= 1024 && item < 1152) {
    const int i = item - 1024;
    samp = true; b = i >> 3; h = i & 7; qrow0 = MP + b * 32; nq = 32; kvrow0 = MP + b * SKV; nkeys = SKV;
  } else {
    const int i = item < 1024 ? item : item - 128;
    const int qb = 63 - (i >> 5), bh = i & 31;
    samp = false; b = bh >> 3; h = bh & 7; qrow0 = b * 4096 + qb * 64; nq = 64; kvrow0 = b * 4096; nkeys = (qb + 1) * 64;
  }
}
DEV int snake_item(int r) {
  const int G = gridDim.x;
  return (r & 1) ? (r * G + (G - 1 - (int)blockIdx.x)) : (r * G + (int)blockIdx.x);
}

DEV void diff_attn_phase(const Params& p, int j, float lam_init, char* smem) {
  char* ws = wsp(p);
  const bf16_t* Q = (const bf16_t*)(ws + B_Q);
  const bf16_t* Kall = (const bf16_t*)(ws + B_K);
  const bf16_t* Vtp = (const bf16_t*)(ws + B_VT);
  const bf16_t* Vts = Vtp + (size_t)4 * 1024 * 4096;
  bf16_t* att = (bf16_t*)(ws + B_ATT);
  const int lane = otid() & 63, wave = otid() >> 6;
  const int l15 = lane & 15, q4 = lane >> 4;
  const float* lv = p.a_lambda + j * 256;
  const float s1 = wave_sum(lv[lane] * lv[64 + lane], lane);
  const float s2 = wave_sum(lv[128 + lane] * lv[192 + lane], lane);
  const float lam = __expf(s1) - __expf(s2) + lam_init;
  const float* gs = p.g_a_sub + j * 128;
  for (int rnd = 0; rnd * (int)gridDim.x < 128 + 2048; ++rnd) {
    const int item = snake_item(rnd);
    if (item >= 128 + 2048) continue;
    int b, h, qrow0, nq, kvrow0, nkeys; bool samp;
    attn_item_decode(item, b, h, qrow0, nq, kvrow0, nkeys, samp);
    const int ql = wave * 16 + l15;
    const int qrow = min(ql, nq - 1);
    const bf16_t* Vb = samp ? (Vts + ((size_t)(b * 1024 + h * 128)) * VTS_LD) : (Vtp + ((size_t)(b * 1024 + h * 128)) * 4096);
    f32x4 O[2][8];
    attn_core<2, 64, true>(Q + (size_t)qrow0 * 1024 + h * 128, 1024, qrow, Kall + (size_t)kvrow0 * 1024 + h * 128, 1024, Vb,
                     samp ? VTS_LD : 4096, nkeys, O, smem);
    float ss = 0.f;
#pragma unroll
    for (int dt = 0; dt < 8; ++dt)
#pragma unroll
      for (int jj = 0; jj < 4; ++jj) {
        const float o = O[0][dt][jj] - lam * O[1][dt][jj];
        O[0][dt][jj] = o;
        ss += o * o;
      }
    ss = xrow16_sum(ss);
    const float r = rsqrtf(ss * (1.f / 128.f) + EPSN) * (1.f - lam_init);
    if (ql < nq) {
      bf16_t* o = att + (size_t)(qrow0 + ql) * 1024 + h * 128;
      f32x4 g4[8];
#pragma unroll
      for (int dt = 0; dt < 8; ++dt) g4[dt] = *(const f32x4*)(gs + dt * 16 + q4 * 4);
#pragma unroll
      for (int dt = 0; dt < 8; ++dt) {
        const int dv = dt * 16 + q4 * 4;
        *reinterpret_cast<uint2*>(o + dv) =
            pack4(O[0][dt][0] * r * g4[dt][0], O[0][dt][1] * r * g4[dt][1], O[0][dt][2] * r * g4[dt][2], O[0][dt][3] * r * g4[dt][3]);
      }
    }
  }
}

DEV void mla_attn_phase(const Params& p, char* smem) {
  char* ws = wsp(p);
  const bf16_t* Q = (const bf16_t*)(ws + B_Q);
  const bf16_t* Kf = (const bf16_t*)(ws + B_K);
  const bf16_t* Vtp = (const bf16_t*)(ws + B_VT);
  const bf16_t* Vts = Vtp + (size_t)4 * 1024 * 4096;
  bf16_t* att = (bf16_t*)(ws + B_ATT);
  const int lane = otid() & 63, wave = otid() >> 6;
  const int l15 = lane & 15, q4 = lane >> 4;
  for (int rnd = 0; rnd * (int)gridDim.x < 128 + 2048; ++rnd) {
    const int item = snake_item(rnd);
    if (item >= 128 + 2048) continue;
    int b, h, qrow0, nq, kvrow0, nkeys; bool samp;
    attn_item_decode(item, b, h, qrow0, nq, kvrow0, nkeys, samp);
    const int ql = wave * 16 + l15;
    const int qrow = min(ql, nq - 1);
    const bf16_t* Vb = samp ? (Vts + ((size_t)(b * 1024 + h * 128)) * VTS_LD) : (Vtp + ((size_t)(b * 1024 + h * 128)) * 4096);
    f32x4 O[1][8];
    attn_core<1, 192, false>(Q + (size_t)qrow0 * 1536 + h * 192, 1536, qrow, Kf + (size_t)kvrow0 * 1536 + h * 192, 1536, Vb,
                      samp ? VTS_LD : 4096, nkeys, O, smem);
    if (ql < nq) {
      bf16_t* o = att + (size_t)(qrow0 + ql) * 1024 + h * 128;
#pragma unroll
      for (int dt = 0; dt < 8; ++dt)
        *reinterpret_cast<uint2*>(o + dt * 16 + q4 * 4) = pack4(O[0][dt][0], O[0][dt][1], O[0][dt][2], O[0][dt][3]);
    }
  }
}

DEV float logsigmoidf_(float x) { return fminf(x, 0.f) - log1pf(__expf(-fabsf(x))); }

DEV void mlstm_gate_phase(const Params& p, char* smem) {
  char* ws = wsp(p);
  const float* Gt = (const float*)(ws + M_GT);
  float* U = (float*)(ws + M_U);
  float* MT = (float*)(ws + M_MT);
  float* BT = (float*)(ws + M_BT);
  float* WR = (float*)(ws + M_WR);
  float* MC = (float*)(ws + M_MC);
  float* DEC = (float*)(ws + M_DEC);
  float* sg = (float*)smem;
  float* su = sg + 64;
  float* sm = su + 64;
  float* sl = sm + 64;
  const int lane = otid() & 63, wave = otid() >> 6;
  for (int s = blockIdx.x; s < 80; s += gridDim.x) {
    const bool samp = s >= 16;
    const int s2 = samp ? s - 16 : s;
    const int b = s2 >> 2, h = s2 & 3;
    const int L = samp ? 32 : 64, NC = samp ? 1 : 64;
    const int row0 = samp ? (MP + b * 32) : (b * 4096);
    const int tok0 = samp ? (65536 + s2 * 32) : (s * 4096);
    const int ch0 = samp ? (1024 + s2) : (s * 64);
    const float bi = p.b_b_gates[h], bfg = p.b_b_gates[4 + h];
    __syncthreads();
    float igv[16], frv[16];
#pragma unroll
    for (int q = 0; q < 16; ++q) {
      const int c = wave + 4 * q;
      if (c < NC) {
        const int t = c * L + min(lane, L - 1);
        igv[q] = Gt[(size_t)(row0 + t) * 8 + h];
        frv[q] = Gt[(size_t)(row0 + t) * 8 + 4 + h];
      }
    }
#pragma unroll
    for (int q = 0; q < 16; ++q) {
      const int c = wave + 4 * q;
      if (c < NC) {
        const bool valid = lane < L;
        const int t = c * L + min(lane, L - 1);
        const float ig = igv[q] + bi;
        const float fr = frv[q] + bfg;
        float bb = valid ? logsigmoidf_(fr) : 0.f;
#pragma unroll
        for (int d = 1; d < 64; d <<= 1) {
          const float v = shfl_lane(bb, lane - d);
          if (lane >= d) bb += v;
        }
        const float u = valid ? (ig - bb) : -INFINITY;
        float pm = u;
#pragma unroll
        for (int d = 1; d < 64; d <<= 1) {
          const float v = shfl_lane(pm, lane - d);
          if (lane >= d) pm = fmaxf(pm, v);
        }
        const float g = __int_as_float(__builtin_amdgcn_readlane(__float_as_int(bb), L - 1));
        const float um = __int_as_float(__builtin_amdgcn_readlane(__float_as_int(pm), L - 1));
        if (valid) {
          BT[tok0 + t] = bb;
          U[tok0 + t] = u;
        }
        igv[q] = u;
        frv[q] = pm;
        if (lane == 0) { sg[c] = g; su[c] = um; }
      }
    }
    __syncthreads();
    if (otid() == 0) {
      float m = samp ? p.state_b_m[s2] : 0.f;
      for (int c = 0; c < NC; ++c) {
        sm[c] = m;
        const float ml = fmaxf(m, su[c]);
        sl[c] = ml;
        m = sg[c] + ml;
      }
      if (samp) p.out[O_BMS + s2] = m; else p.out[O_BMP + s] = m;
    }
    __syncthreads();
#pragma unroll
    for (int q = 0; q < 16; ++q) {
      const int c = wave + 4 * q;
      if (c < NC) {
        const float mc = sm[c], ml = sl[c];
        if (lane < L) {
          const int t = c * L + lane;
          MT[tok0 + t] = fmaxf(mc, frv[q]);
          WR[tok0 + t] = __expf(igv[q] - ml);
        }
        if (lane == 0) { MC[ch0 + c] = mc; DEC[ch0 + c] = __expf(mc - ml); }
      }
    }
  }
  __syncthreads();
}

template <int KS>
DEV void mlstm_state_item(const Params& p, int s2, bool samp, int dt) {
  char* ws = wsp(p);
  const int lane = otid() & 63, wave = otid() >> 6;
  const int l15 = lane & 15, q4 = lane >> 4;
  constexpr int L = KS * 32;
  const int NC = samp ? 1 : 64;
  const int ldt = samp ? 32 : 4096;
  const bf16_t* Vx = samp ? ((const bf16_t*)(ws + M_VXS) + ((size_t)(s2 * 272 + dt * 16)) * 32)
                          : ((const bf16_t*)(ws + M_VXP) + ((size_t)(s2 * 272 + dt * 16)) * 4096);
  const bf16_t* Kt = samp ? ((const bf16_t*)(ws + M_KT) + (size_t)16 * 128 * 4096 + (size_t)s2 * 128 * 32)
                          : ((const bf16_t*)(ws + M_KT) + (size_t)s2 * 128 * 4096);
  const float* WR = (const float*)(ws + M_WR) + (samp ? (65536 + s2 * 32) : (s2 * 4096));
  const float* DEC = (const float*)(ws + M_DEC) + (samp ? (1024 + s2) : (s2 * 64));
  bf16_t* CT = (bf16_t*)(ws + M_CT) + (size_t)(samp ? (1024 + s2) : (s2 * 64)) * 272 * 128;
  f32x4 acc[2];
#pragma unroll
  for (int nt = 0; nt < 2; ++nt) {
    const int dq = wave * 32 + nt * 16 + l15;
#pragma unroll
    for (int j = 0; j < 4; ++j) {
      float v = 0.f;
      if (samp) {
        if (dt < 16) v = p.state_b_c[((size_t)(s2 * 128 + dq)) * 256 + dt * 16 + q4 * 4 + j];
        else if (q4 == 0 && j == 0) v = p.state_b_n[s2 * 128 + dq];
      }
      acc[nt][j] = v;
    }
  }
  bf16x8 vr[KS], kb[KS][2];
  f32x4 w0[KS], w1[KS];
  float dec;
  auto load_ops = [&](int c, bf16x8 (&vr_)[KS], bf16x8 (&kb_)[KS][2], f32x4 (&w0_)[KS], f32x4 (&w1_)[KS], float& dec_) {
    dec_ = DEC[c];
#pragma unroll
    for (int ks = 0; ks < KS; ++ks) {
      const int t0 = c * L + ks * 32 + q4 * 8;
      vr_[ks] = ld8(Vx + (size_t)l15 * ldt + t0);
      w0_[ks] = *(const f32x4*)(WR + t0);
      w1_[ks] = *(const f32x4*)(WR + t0 + 4);
#pragma unroll
      for (int nt = 0; nt < 2; ++nt) kb_[ks][nt] = ld8(Kt + (size_t)(wave * 32 + nt * 16 + l15) * ldt + t0);
    }
  };
  load_ops(0, vr, kb, w0, w1, dec);
  for (int c = 0; c < NC; ++c) {
    bf16x8 vrn[KS], kbn[KS][2];
    f32x4 w0n[KS], w1n[KS];
    float decn = 0.f;
    if (c + 1 < NC) load_ops(c + 1, vrn, kbn, w0n, w1n, decn);
#pragma unroll
    for (int nt = 0; nt < 2; ++nt)
#pragma unroll
      for (int j = 0; j < 4; ++j)
        CT[((size_t)c * 272 + dt * 16 + q4 * 4 + j) * 128 + wave * 32 + nt * 16 + l15] = f2bf(acc[nt][j]);
#pragma unroll
    for (int nt = 0; nt < 2; ++nt) { acc[nt][0] *= dec; acc[nt][1] *= dec; acc[nt][2] *= dec; acc[nt][3] *= dec; }
#pragma unroll
    for (int ks = 0; ks < KS; ++ks) {
      u32x4 vp;
      vp[0] = pack2(bf2f((bf16_t)vr[ks][0]) * w0[ks][0], bf2f((bf16_t)vr[ks][1]) * w0[ks][1]);
      vp[1] = pack2(bf2f((bf16_t)vr[ks][2]) * w0[ks][2], bf2f((bf16_t)vr[ks][3]) * w0[ks][3]);
      vp[2] = pack2(bf2f((bf16_t)vr[ks][4]) * w1[ks][0], bf2f((bf16_t)vr[ks][5]) * w1[ks][1]);
      vp[3] = pack2(bf2f((bf16_t)vr[ks][6]) * w1[ks][2], bf2f((bf16_t)vr[ks][7]) * w1[ks][3]);
      const bf16x8 va = __builtin_bit_cast(bf16x8, vp);
#pragma unroll
      for (int nt = 0; nt < 2; ++nt) acc[nt] = mfma16(va, kb[ks][nt], acc[nt]);
    }
    if (c + 1 < NC) {
      dec = decn;
#pragma unroll
      for (int ks = 0; ks < KS; ++ks) {
        vr[ks] = vrn[ks]; w0[ks] = w0n[ks]; w1[ks] = w1n[ks]; kb[ks][0] = kbn[ks][0]; kb[ks][1] = kbn[ks][1];
      }
    }
  }
  float* oc = samp ? (p.out + O_BCS + (size_t)s2 * 128 * 256) : (p.out + O_BCP + (size_t)s2 * 128 * 256);
  float* on = samp ? (p.out + O_BNS + (size_t)s2 * 128) : (p.out + O_BNP + (size_t)s2 * 128);
#pragma unroll
  for (int nt = 0; nt < 2; ++nt) {
    const int dq = wave * 32 + nt * 16 + l15;
    if (dt < 16) {
      float4 v; v.x = acc[nt][0]; v.y = acc[nt][1]; v.z = acc[nt][2]; v.w = acc[nt][3];
      *(float4*)(oc + (size_t)dq * 256 + dt * 16 + q4 * 4) = v;
    } else if (q4 == 0) {
      on[dq] = acc[nt][0];
    }
  }
}

DEV void mlstm_state_phase(const Params& p) {
  for (int item = blockIdx.x; item < 272 + 1088; item += gridDim.x) {
    if (item < 272) mlstm_state_item<2>(p, item / 17, false, item % 17);
    else { const int w = item - 272; mlstm_state_item<1>(p, w / 17, true, w % 17); }
  }
}

DEV void mlstm_out_phase(const Params& p, char* smem) {
  char* ws = wsp(p);
  const bf16_t* Qb = (const bf16_t*)(ws + B_Q);
  const bf16_t* Kb = (const bf16_t*)(ws + B_K);
  const bf16_t* Opre = (const bf16_t*)(ws + M_OPRE);
  bf16_t* Hn = (bf16_t*)(ws + B_ATT);
  bf16_t* sK = (bf16_t*)smem;
  bf16_t* sV = sK + 64 * 136;
  const int tid = otid(), lane = tid & 63, wave = tid >> 6;
  const int l15 = lane & 15, q4 = lane >> 4;
  for (int item = blockIdx.x; item < 1024 + 64; item += gridDim.x) {
    const bool samp = item >= 1024;
    const int s2 = samp ? item - 1024 : (item >> 6);
    const int c = samp ? 0 : (item & 63);
    const int b = s2 >> 2, h = s2 & 3;
    const int L = samp ? 32 : 64;
    const int rowbase = samp ? (MP + b * 32) : (b * 4096 + c * 64);
    const int tok0 = samp ? (65536 + s2 * 32) : (s2 * 4096 + c * 64);
    const int chi = samp ? (1024 + s2) : (s2 * 64 + c);
    const bf16_t* Vx = samp ? ((const bf16_t*)(ws + M_VXS) + (size_t)s2 * 272 * 32)
                            : ((const bf16_t*)(ws + M_VXP) + (size_t)s2 * 272 * 4096 + c * 64);
    const int ldt = samp ? 32 : 4096;
    const bf16_t* CT = (const bf16_t*)(ws + M_CT) + (size_t)chi * 272 * 128;
    const float* U = (const float*)(ws + M_U) + tok0;
    const float* MT = (const float*)(ws + M_MT) + tok0;
    const float* BT = (const float*)(ws + M_BT) + tok0;
    const float mc = ((const float*)(ws + M_MC))[chi];
    const int tl = wave * 16 + l15;
    const int tcl = min(tl, L - 1);
    __syncthreads();
#pragma unroll
    for (int i = 0; i < 4; ++i) {
      const int cc = tid + i * 256, r = cc >> 4, kc = cc & 15;
      *reinterpret_cast<uint4*>(sK + r * 136 + kc * 8) =
          *reinterpret_cast<const uint4*>(Kb + (size_t)(rowbase + min(r, L - 1)) * 512 + h * 128 + kc * 8);
    }
#pragma unroll
    for (int i = 0; i < 9; ++i) {
      const int cc = tid + i * 256;
      if (cc < 2176) {
        const int r = cc >> 3, kc = cc & 7;
        uint4 v = make_uint4(0, 0, 0, 0);
        if (kc * 8 < L) v = *reinterpret_cast<const uint4*>(Vx + (size_t)r * ldt + kc * 8);
        *reinterpret_cast<uint4*>(sV + r * 72 + kc * 8) = v;
      }
    }
    bf16x8 qf[4];
#pragma unroll
    for (int ks = 0; ks < 4; ++ks) qf[ks] = ld8(Qb + (size_t)(rowbase + tcl) * 512 + h * 128 + ks * 32 + q4 * 8);
    const float Mt_t = MT[tcl], bt_t = BT[tcl];
    const float a_t = __expf(mc - Mt_t);
    __syncthreads();
    bf16x8 pf[2];
    {
      f32x4 st[4];
#pragma unroll
      for (int t4 = 0; t4 < 4; ++t4) {
        st[t4] = (f32x4){0.f, 0.f, 0.f, 0.f};
#pragma unroll
        for (int ks = 0; ks < 4; ++ks) st[t4] = mfma16(ld8(sK + (t4 * 16 + l15) * 136 + ks * 32 + q4 * 8), qf[ks], st[t4]);
        const float4 u4 = *(const float4*)(U + t4 * 16 + q4 * 4);
        const int sb = t4 * 16 + q4 * 4;
        st[t4][0] = (sb + 0 <= tl && sb + 0 < L) ? st[t4][0] * __expf(u4.x - Mt_t) : 0.f;
        st[t4][1] = (sb + 1 <= tl && sb + 1 < L) ? st[t4][1] * __expf(u4.y - Mt_t) : 0.f;
        st[t4][2] = (sb + 2 <= tl && sb + 2 < L) ? st[t4][2] * __expf(u4.z - Mt_t) : 0.f;
        st[t4][3] = (sb + 3 <= tl && sb + 3 < L) ? st[t4][3] * __expf(u4.w - Mt_t) : 0.f;
      }
      pf[0] = packP(st[0], st[1]);
      pf[1] = packP(st[2], st[3]);
    }
    f32x4 acc[17];
#pragma unroll
    for (int dt = 0; dt < 17; ++dt) {
      acc[dt] = (f32x4){0.f, 0.f, 0.f, 0.f};
#pragma unroll
      for (int ks = 0; ks < 4; ++ks)
        acc[dt] = mfma16(ld8(CT + (size_t)(dt * 16 + l15) * 128 + ks * 32 + q4 * 8), qf[ks], acc[dt]);
      acc[dt][0] *= a_t; acc[dt][1] *= a_t; acc[dt][2] *= a_t; acc[dt][3] *= a_t;
#pragma unroll
      for (int kk = 0; kk < 2; ++kk) {
        const bf16_t* vb = sV + (dt * 16 + l15) * 72 + kk * 32 + q4 * 4;
        acc[dt] = mfma16(ld2x4(vb, vb + 16), pf[kk], acc[dt]);
      }
    }
    const float den = shfl_lane(acc[16][0], l15);
    const float dn = fmaxf(fabsf(den), __expf(-(bt_t + Mt_t)));
    const float idn = 1.f / dn;
    float ss = 0.f;
#pragma unroll
    for (int dt = 0; dt < 16; ++dt)
#pragma unroll
      for (int j = 0; j < 4; ++j) {
        const float hv = acc[dt][j] * idn;
        acc[dt][j] = hv;
        ss += hv * hv;
      }
    ss = xrow16_sum(ss);
    const float r = rsqrtf(ss * (1.f / 256.f) + EPSN);
    if (tl < L) {
      const size_t ro = (size_t)(rowbase + tl) * 1024 + h * 256;
      const float* gbo = p.g_b_out + h * 256;
      f32x4 g4[16];
      uint32_t obx[16], oby[16];
#pragma unroll
      for (int dt = 0; dt < 16; ++dt) {
        const int dv = dt * 16 + q4 * 4;
        g4[dt] = *(const f32x4*)(gbo + dv);
        obx[dt] = *reinterpret_cast<const uint32_t*>(Opre + ro + dv);
        oby[dt] = *reinterpret_cast<const uint32_t*>(Opre + ro + dv + 2);
      }
#pragma unroll
      for (int dt = 0; dt < 16; ++dt) {
        const int dv = dt * 16 + q4 * 4;
        const float o0 = bf2f((bf16_t)(obx[dt] & 0xffff)), o1 = bf2f((bf16_t)(obx[dt] >> 16));
        const float o2 = bf2f((bf16_t)(oby[dt] & 0xffff)), o3 = bf2f((bf16_t)(oby[dt] >> 16));
        *reinterpret_cast<uint2*>(Hn + ro + dv) =
            pack4(acc[dt][0] * r * g4[dt][0] * o0, acc[dt][1] * r * g4[dt][1] * o1, acc[dt][2] * r * g4[dt][2] * o2, acc[dt][3] * r * g4[dt][3] * o3);
      }
    }
  }
  __syncthreads();
}

#define XB_TMO      128
#define XB_XCNT(j)  (256  + 64 * (j))
#define XB_XSUB(j)  (1280 + 64 * (j))
#define XB_XGEN(j)  (2304 + 64 * (j))
#define XB_TOP      3328
#define XB_TOPGEN   3392
#define XCD_BAR_WORDS 3456
#define XB_SPIN_CAP (1u << 20)
#define LAS __attribute__((address_space(3)))
DEV unsigned xb_ld(unsigned* p) { return __hip_atomic_load(p, __ATOMIC_RELAXED, __HIP_MEMORY_SCOPE_AGENT); }
DEV unsigned xb_add(unsigned* p, unsigned v) { return __hip_atomic_fetch_add(p, v, __ATOMIC_RELAXED, __HIP_MEMORY_SCOPE_AGENT); }
DEV unsigned xb_xcc_id() { return (unsigned)__builtin_amdgcn_s_getreg((3 << 11) | 20) & 0xFu; }
#define XB_SPIN(cond, bar) do { unsigned _sp = 0; while (cond) { __builtin_amdgcn_s_sleep(1); \
    if ((++_sp & 255u) == 0u) { if (xb_ld(&(bar)[XB_TMO])) break; if (_sp > XB_SPIN_CAP) { atomicAdd(&(bar)[XB_TMO], 1u); break; } } } } while (0)

DEV void xcd_barrier_complete(unsigned* bar, unsigned x, unsigned& nloc, unsigned& nx) {
  const unsigned G = gridDim.x;
  unsigned sum, cnt, mine, sp = 0u;
  for (;;) {
    sum = 0u; cnt = 0u; mine = 0u;
#pragma unroll
    for (unsigned j = 0; j < 16; ++j) {
      const unsigned c = xb_ld(&bar[XB_XCNT(j)]);
      sum += c; cnt += (c > 0u) ? 1u : 0u; mine = (j == x) ? c : mine;
    }
    if (sum == G) break;
    __builtin_amdgcn_s_sleep(1);
    if ((++sp & 255u) == 0u) { if (xb_ld(&bar[XB_TMO])) break; if (sp > XB_SPIN_CAP) { atomicAdd(&bar[XB_TMO], 1u); break; } }
  }
  nloc = mine > 0u ? mine : 1u; nx = cnt > 0u ? cnt : 1u;
}
DEV void gbar_post(const Params& p) {
  if (threadIdx.x == 0) {
    unsigned* bar = (unsigned*)(wsp(p) + B_BAR);
    (void)xb_add(&bar[XB_XCNT(xb_xcc_id())], 1u);
  }
}
DEV void gbar(const Params& p, volatile LAS unsigned* st) {
  asm volatile("s_waitcnt vmcnt(0)" ::: "memory");
  __syncthreads();
  if (threadIdx.x == 0) {
    unsigned* bar = (unsigned*)(wsp(p) + B_BAR);
    const unsigned x = xb_xcc_id();
    __builtin_amdgcn_s_waitcnt(0);
    unsigned nloc = st[0], nx = st[1];
    if (nloc == 0u) { xcd_barrier_complete(bar, x, nloc, nx); st[0] = nloc; st[1] = nx; }
    const unsigned old = xb_add(&bar[XB_XSUB(x)], 1u);
    const unsigned gen = old / nloc;
    if (old + 1u == (gen + 1u) * nloc) {
      __builtin_amdgcn_fence(__ATOMIC_RELEASE, "agent");
      asm volatile("s_waitcnt vmcnt(0)" ::: "memory");
      const unsigned og = xb_add(&bar[XB_TOP], 1u);
      const unsigned tg = og / nx;
      if (og + 1u == (tg + 1u) * nx) xb_add(&bar[XB_TOPGEN], 1u);
      else XB_SPIN(xb_ld(&bar[XB_TOPGEN]) == tg, bar);
      __builtin_amdgcn_fence(__ATOMIC_ACQUIRE, "agent");
      xb_add(&bar[XB_XGEN(x)], 1u);
      asm volatile("s_waitcnt vmcnt(0)" ::: "memory");
    } else {
      XB_SPIN(xb_ld(&bar[XB_XGEN(x)]) == gen, bar);
      __builtin_amdgcn_fence(__ATOMIC_ACQUIRE, "agent");
      asm volatile("s_waitcnt vmcnt(0)" ::: "memory");
    }
  }
  __syncthreads();
}

__global__ void __launch_bounds__(256, 2) mega_kernel(Params kp) {
  cg::grid_group grid = cg::this_grid();
  __shared__ __attribute__((aligned(16))) char smem[SMEM_BYTES];
  __shared__ Params p;
  __shared__ uint4 xb_words;
  if (threadIdx.x == 0) { p = kp; xb_words = make_uint4(0u, 0u, 0u, 0u); }
  __syncthreads();
  if (blockIdx.x == 0) {
    unsigned* bar = (unsigned*)(wsp(p) + B_BAR);
    for (int i = threadIdx.x; i < XCD_BAR_WORDS; i += 256) bar[i] = 0u;
  }
  phase0(p, smem);
  grid.sync();
  gbar_post(p);
#define GSYNC() gbar(p, (volatile LAS unsigned*)&xb_words)

  for (int layer = 0; layer < 4; ++layer) {
    const int kind = layer % 3, j = layer / 3;
    {
      char* ws = wsp(p);
      norm_mod_phase((float*)(ws + B_X), p.g_norm1 + layer * 1024, (const float*)(ws + B_MOD) + (size_t)layer * 20 * 6144, 0, 1024, (bf16_t*)(ws + B_H),
                     (const float*)(ws + B_PART), layer > 0 ? 11 : 0);
    }
    if (kind == 0) { if (j == 0) conv_cache_a(p, 0, smem); }
    else if (kind == 1) init_vx_rows(p);
    else conv_cache_c(p);
    GSYNC();
    if (kind == 0) {
      {
        char* ws = wsp(p);
        float* out = p.out;
        EpiQKV e;
        e.Q = (bf16_t*)(ws + B_Q); e.Kall = (bf16_t*)(ws + B_K); e.Vtp = (bf16_t*)(ws + B_VT); e.Vts = e.Vtp + (size_t)4 * 1024 * 4096;
        e.ropa = (const float2*)(ws + B_ROPA);
        e.akp = out + O_AKP + (size_t)j * MP * 1024; e.aks = out + O_AKS + (size_t)j * MS * 1024;
        e.avp = out + O_AVP + (size_t)j * MP * 1024; e.avs = out + O_AVS + (size_t)j * MS * 1024;
        gemm_wide_phase<true>((const bf16_t*)(ws + B_H), 1024, (const bf16_t*)(ws + W_QKV) + (size_t)j * 3072 * 1024, 1024, MA / 128, 12, 1024, e, smem);
      }
      GSYNC();
      diff_attn_phase(p, j, j == 0 ? p.lam_init0 : p.lam_init3, smem);
      GSYNC();
      {
        char* ws = wsp(p);
        EpiRes r; r.x = (float*)(ws + B_X); r.gate = (const float*)(ws + B_MOD) + (size_t)layer * 20 * 6144 + 2048;
        gemm_res_phase((const bf16_t*)(ws + B_ATT), 1024, (const bf16_t*)(ws + W_AO) + (size_t)j * 1024 * 1024, 1024, 1024, 16, r, (float*)(ws + B_PART), smem);
      }
      GSYNC();
    } else if (kind == 1) {
      {
        char* ws = wsp(p);
        EpiBin e;
        e.Qb = (bf16_t*)(ws + B_Q); e.Kb = (bf16_t*)(ws + B_K); e.Ktp = (bf16_t*)(ws + M_KT); e.Kts = e.Ktp + (size_t)16 * 128 * 4096;
        e.Vxp = (bf16_t*)(ws + M_VXP); e.Vxs = (bf16_t*)(ws + M_VXS); e.Opre = (bf16_t*)(ws + M_OPRE);
        e.Gt = (float*)(ws + M_GT);
        gemm_wide_phase<false>((const bf16_t*)(ws + B_H), 1024, (const bf16_t*)(ws + W_BIN), 1024, MA / 128, 13, 1024, e, smem);
      }
      GSYNC();
      mlstm_gate_phase(p, smem);
      GSYNC();
      mlstm_state_phase(p);
      GSYNC();
      mlstm_out_phase(p, smem);
      GSYNC();
      {
        char* ws = wsp(p);
        EpiRes r; r.x = (float*)(ws + B_X); r.gate = (const float*)(ws + B_MOD) + (size_t)layer * 20 * 6144 + 2048;
        gemm_res_phase((const bf16_t*)(ws + B_ATT), 1024, (const bf16_t*)(ws + W_BOUT), 1024, 1024, 16, r, (float*)(ws + B_PART), smem);
      }
      GSYNC();
    } else {
      {
        char* ws = wsp(p);
        EpiF32 e; e.raw = (float*)(ws + C_RAW);
        gemm_phase((const bf16_t*)(ws + B_H), 1024, (const bf16_t*)(ws + W_CD), 1024, MA / 128, 6, 1024, e, smem);
      }
      GSYNC();
      mla_norm_phase(p);
      GSYNC();
      {
        char* ws = wsp(p);
        EpiUQ eq; eq.Qc = (bf16_t*)(ws + B_Q); eq.ropc = (const float2*)(ws + B_ROPC);
        gemm_phase((const bf16_t*)(ws + C_QN), 384, (const bf16_t*)(ws + W_UQ), 384, MA / 128, 12, 384, eq, smem);
      }
      {
        char* ws = wsp(p);
        EpiUKV ek; ek.Kf = (bf16_t*)(ws + B_K); ek.Vtp = (bf16_t*)(ws + B_VT); ek.Vts = ek.Vtp + (size_t)4 * 1024 * 4096;
        gemm_phase((const bf16_t*)(ws + C_KVB), 256, (const bf16_t*)(ws + W_UKV), 256, KVROWS / 128, 16, 256, ek, smem);
      }
      GSYNC();
      mla_attn_phase(p, smem);
      GSYNC();
      {
        char* ws = wsp(p);
        EpiRes r; r.x = (float*)(ws + B_X); r.gate = (const float*)(ws + B_MOD) + (size_t)layer * 20 * 6144 + 2048;
        gemm_res_phase((const bf16_t*)(ws + B_ATT), 1024, (const bf16_t*)(ws + W_CO), 1024, 1024, 16, r, (float*)(ws + B_PART), smem);
      }
      GSYNC();
    }
    {
      char* ws = wsp(p);
      norm_mod_phase((float*)(ws + B_X), p.g_norm2 + layer * 1024, (const float*)(ws + B_MOD) + (size_t)layer * 20 * 6144, 3072, 4096, (bf16_t*)(ws + B_H),
                     (const float*)(ws + B_PART), 16);
    }
    GSYNC();
    {
      char* ws = wsp(p);
      EpiSwiglu e; e.act = (bf16_t*)(ws + B_ACT);
      const bool side = (layer == 2);
      const bool first = blockIdx.x >= (gridDim.x >> 1);
      if (side && first) conv_cache_a(p, 1, smem);
      gemm_wide_phase<false>((const bf16_t*)(ws + B_H), 1024, (const bf16_t*)(ws + W_FIN) + (size_t)layer * 5632 * 1024, 1024, MA / 128, 22, 1024, e, smem);
      if (side && !first) conv_cache_a(p, 1, smem);
    }
    GSYNC();
    {
      char* ws = wsp(p);
      EpiRes r; r.x = (float*)(ws + B_X); r.gate = (const float*)(ws + B_MOD) + (size_t)layer * 20 * 6144 + 5120;
      gemm_res_phase((const bf16_t*)(ws + B_ACT), 2816, (const bf16_t*)(ws + W_FOUT) + (size_t)layer * 1024 * 2816, 2816, 2816, 11, r, (float*)(ws + B_PART), smem);
    }
    GSYNC();
  }
  {
    char* ws = wsp(p);
    final_norm_phase((const float*)(ws + B_X), p.g_final, p.out, (const float*)(ws + B_PART), 11);
  }
}

extern "C" void kernel_launch(void* const* d_in, const int* in_sizes, int n_in, void* d_out, int out_size, void* d_ws,
                              size_t ws_size, hipStream_t stream) {
  static int grid_blocks = 0;
  if (!grid_blocks) {
    int dev = 0, cus = 0, per_cu = 0;
    hipGetDevice(&dev);
    hipDeviceGetAttribute(&cus, hipDeviceAttributeMultiprocessorCount, dev);
    hipOccupancyMaxActiveBlocksPerMultiprocessor(&per_cu, mega_kernel, 256, 0);
    if (per_cu > 2) per_cu = 2;
    if (per_cu < 1) per_cu = 1;
    grid_blocks = (cus * per_cu) & ~7;
    if (grid_blocks < 8) grid_blocks = 8;
  }
  Params p{};
  const float* const* in = (const float* const*)d_in;
  p.x_prompt = in[0]; p.x_sample = in[1]; p.c_prompt = in[2]; p.c_sample = in[3]; p.cache_a_k = in[4];
  p.cache_a_v = in[5]; p.state_b_c = in[6]; p.state_b_n = in[7]; p.state_b_m = in[8]; p.cache_c_kv = in[9];
  p.cache_c_kr = in[10]; p.w_ada = in[11]; p.b_ada = in[12]; p.g_norm1 = in[13]; p.g_norm2 = in[14];
  p.w_a_qkv = in[15]; p.a_lambda = in[16]; p.g_a_sub = in[17]; p.w_a_o = in[18]; p.w_b_in = in[19];
  p.b_b_gates = in[20]; p.g_b_out = in[21]; p.w_b_out = in[22]; p.w_c_dq = in[23]; p.g_c_q = in[24];
  p.w_c_uq = in[25]; p.w_c_dkv = in[26]; p.g_c_kv = in[27]; p.w_c_ukv = in[28]; p.w_c_o = in[29];
  p.w_ffn_in = in[30]; p.w_ffn_out = in[31]; p.g_final = in[32];
  p.out = (float*)d_out;
  p.ws = (char*)d_ws;
  p.lam_init0 = (float)(0.8 - 0.6 * exp(-0.3 * 0.0));
  p.lam_init3 = (float)(0.8 - 0.6 * exp(-0.3 * 3.0));
  void* args[] = {&p};
  hipError_t e = hipLaunchCooperativeKernel((void*)mega_kernel, dim3(grid_blocks), dim3(256), args, 0, stream);
  if (e != hipSuccess) fprintf(stderr, "cooperative launch failed: %s (grid %d)\n", hipGetErrorString(e), grid_blocks);
}
```
